# Optimizing an MI355X kernel written in HIP

```python
import math
import jax, jax.numpy as jnp
from jax import lax
import numpy as np

D_MODEL = 1024
BATCH = 32
SEQ = 2048
DEPTH = 1
DEC_BATCH = 32
DEC_SEQ = 32
PAST_LEN = 2048

CHUNK = 64
Q_BLOCK = 128
EPS = 1e-6
NEG_INF = -1e30
MLA_HEADS = 8
QK_NOPE = 64
QK_ROPE = 32
V_HEAD = 64
Q_LORA = 384
KV_LORA = 256
ROPE_BASE = 10000.0
MLA_WIDTH = MLA_HEADS * V_HEAD
ATTN_SCALE = (QK_NOPE + QK_ROPE) ** -0.5
S5_WIDTH = D_MODEL - MLA_WIDTH
S5_GROUP_CH = 16
S5_GROUPS = S5_WIDTH // S5_GROUP_CH
S5_STATE = 64
MIX_WIDTH = MLA_WIDTH + S5_WIDTH
IN_WIDTH = Q_LORA + KV_LORA + QK_ROPE + S5_WIDTH
D_FF = ((8 * D_MODEL + 3 * 256 - 1) // (3 * 256)) * 256

kernel_name = "hymba_mla_s5_streaming_step"


def _rmsnorm(x, g):
    xf = x.astype(jnp.float32)
    y = xf * lax.rsqrt(jnp.mean(xf * xf, axis=-1, keepdims=True) + EPS)
    return (y * g.astype(jnp.float32)).astype(x.dtype)


def _rope_tables(pos):
    inv = 1.0 / (ROPE_BASE ** (jnp.arange(0, QK_ROPE, 2, dtype=jnp.float32) / QK_ROPE))
    ang = pos.astype(jnp.float32)[:, None] * inv[None, :]
    return jnp.cos(ang), jnp.sin(ang)


def _apply_rope(x, cos, sin):
    half = QK_ROPE // 2
    x1 = x[..., :half].astype(jnp.float32)
    x2 = x[..., half:].astype(jnp.float32)
    return jnp.concatenate([x1 * cos - x2 * sin, x2 * cos + x1 * sin], axis=-1).astype(x.dtype)


def _attend(q_nope, q_rope, k_nope, k_rope, v, q_pos, k_pos):
    s = (jnp.einsum("bqhd,bkhd->bhqk", q_nope, k_nope)
         + jnp.einsum("bqhr,bkr->bhqk", q_rope, k_rope))
    s = s.astype(jnp.float32) * ATTN_SCALE
    visible = (k_pos[None, :] // CHUNK) <= (q_pos[:, None] // CHUNK)
    s = jnp.where(visible[None, None], s, NEG_INF)
    p = jax.nn.softmax(s, axis=-1).astype(v.dtype)
    return jnp.einsum("bhqk,bkhd->bqhd", p, v)


def _attend_blocked(q_nope, q_rope, k_nope, k_rope, v, q_pos, k_pos):
    bsz, lq = q_nope.shape[:2]
    if lq <= Q_BLOCK:
        return _attend(q_nope, q_rope, k_nope, k_rope, v, q_pos, k_pos)
    nb = lq // Q_BLOCK
    qn = jnp.moveaxis(q_nope.reshape(bsz, nb, Q_BLOCK, MLA_HEADS, QK_NOPE), 1, 0)
    qr = jnp.moveaxis(q_rope.reshape(bsz, nb, Q_BLOCK, MLA_HEADS, QK_ROPE), 1, 0)
    qp = q_pos.reshape(nb, Q_BLOCK)
    out = lax.map(lambda blk: _attend(blk[0], blk[1], k_nope, k_rope, v, blk[2], k_pos), (qn, qr, qp))
    return jnp.moveaxis(out, 0, 1).reshape(bsz, lq, MLA_HEADS, V_HEAD)


def _cmul(ar, ai, br, bi):
    return ar * br - ai * bi, ar * bi + ai * br


def _scan_combine(e1, e2):
    a1r, a1i, b1r, b1i = e1
    a2r, a2i, b2r, b2i = e2
    ar, ai = _cmul(a2r, a2i, a1r, a1i)
    br, bi = _cmul(a2r, a2i, b1r, b1i)
    return ar, ai, br + b2r, bi + b2i


def _s5(u, x0_re, x0_im, a_re, a_im, log_dt, b_re, b_im, c_re, c_im, d_skip, w_glu, b_glu):
    f32 = jnp.float32
    bsz, length, _ = u.shape
    uf = u.astype(f32).reshape(bsz, length, S5_GROUPS, S5_GROUP_CH)
    dt = jnp.exp(log_dt.astype(f32))[:, None]
    lr, li = a_re.astype(f32), a_im.astype(f32)
    mag, ang = jnp.exp(lr * dt), li * dt
    abr, abi = mag * jnp.cos(ang), mag * jnp.sin(ang)
    den = lr * lr + li * li
    zr, zi = _cmul(abr - 1.0, abi, lr / den, -li / den)
    bbr, bbi = _cmul(zr[..., None], zi[..., None], b_re.astype(f32), b_im.astype(f32))
    bur = jnp.einsum("blgc,gpc->blgp", uf, bbr)
    bui = jnp.einsum("blgc,gpc->blgp", uf, bbi)
    x0r, x0i = _cmul(abr, abi, x0_re.astype(f32), x0_im.astype(f32))
    bur = bur.at[:, 0].add(x0r)
    bui = bui.at[:, 0].add(x0i)
    ar_seq = jnp.broadcast_to(abr, (1, length, S5_GROUPS, S5_STATE))
    ai_seq = jnp.broadcast_to(abi, (1, length, S5_GROUPS, S5_STATE))
    _, _, xr, xi = lax.associative_scan(_scan_combine, (ar_seq, ai_seq, bur, bui), axis=1)
    y = (jnp.einsum("blgp,gcp->blgc", xr, c_re.astype(f32))
         - jnp.einsum("blgp,gcp->blgc", xi, c_im.astype(f32))
         + uf * d_skip.astype(f32).reshape(S5_GROUPS, S5_GROUP_CH))
    z = jax.nn.gelu(y.reshape(bsz, length, S5_WIDTH))
    out = z * jax.nn.sigmoid(z @ w_glu.astype(f32) + b_glu.astype(f32))
    return out.astype(u.dtype), xr[:, -1], xi[:, -1]


def _block(x, pos, past_ckv, past_krope, x0_re, x0_im,
           g_mix, w_in, g_q, w_uq, g_kv, w_ukv,
           s5_a_re, s5_a_im, s5_log_dt, s5_b_re, s5_b_im, s5_c_re, s5_c_im, s5_d, w_glu, b_glu,
           g_out_mla, g_out_s5, w_out, g_ffn, w_gate, w_up, w_down):
    bsz, length, _ = x.shape
    h = _rmsnorm(x, g_mix)
    proj = h @ w_in
    o1 = Q_LORA
    o2 = o1 + KV_LORA
    o3 = o2 + QK_ROPE
    c_q, c_kv, k_r, u = proj[..., :o1], proj[..., o1:o2], proj[..., o2:o3], proj[..., o3:]
    cos, sin = _rope_tables(pos)
    q = (_rmsnorm(c_q, g_q) @ w_uq).reshape(bsz, length, MLA_HEADS, QK_NOPE + QK_ROPE)
    q_nope = q[..., :QK_NOPE]
    q_rope = _apply_rope(q[..., QK_NOPE:], cos[:, None, :], sin[:, None, :])
    ckv = _rmsnorm(c_kv, g_kv)
    krope = _apply_rope(k_r, cos, sin)
    if past_ckv is None:
        all_ckv, all_kr, k_pos = ckv, krope, pos
    else:
        all_ckv = jnp.concatenate([past_ckv.astype(ckv.dtype), ckv], axis=1)
        all_kr = jnp.concatenate([past_krope.astype(krope.dtype), krope], axis=1)
        k_pos = jnp.arange(past_ckv.shape[1] + length)
    kv = (all_ckv @ w_ukv).reshape(bsz, all_ckv.shape[1], MLA_HEADS, QK_NOPE + V_HEAD)
    attn = _attend_blocked(q_nope, q_rope, kv[..., :QK_NOPE], all_kr, kv[..., QK_NOPE:], pos, k_pos)
    ssm, xr, xi = _s5(u, x0_re, x0_im, s5_a_re, s5_a_im, s5_log_dt, s5_b_re, s5_b_im,
                      s5_c_re, s5_c_im, s5_d, w_glu, b_glu)
    mixed = jnp.concatenate([_rmsnorm(attn.reshape(bsz, length, MLA_WIDTH), g_out_mla),
                             _rmsnorm(ssm, g_out_s5)], axis=-1)
    x = x + mixed @ w_out
    h2 = _rmsnorm(x, g_ffn)
    x = x + (jax.nn.silu(h2 @ w_gate) * (h2 @ w_up)) @ w_down
    return x, ckv, krope, xr.astype(x.dtype), xi.astype(x.dtype)


def setup_inputs(seed: int = 0) -> dict:
    key = jax.random.key(seed)
    ks = jax.random.split(key, 32)
    f32 = jnp.float32

    def nrm(k, shape, scale):
        return jax.random.normal(k, shape, f32) * scale

    L = DEPTH
    return {
        "x_prompt": nrm(ks[0], (BATCH, SEQ, D_MODEL), 1.0),
        "x_sample": nrm(ks[1], (DEC_BATCH, DEC_SEQ, D_MODEL), 1.0),
        "cache_mla_ckv": nrm(ks[2], (L, DEC_BATCH, PAST_LEN, KV_LORA), 1.0),
        "cache_mla_krope": nrm(ks[3], (L, DEC_BATCH, PAST_LEN, QK_ROPE), 1.0),
        "state_s5_re": nrm(ks[4], (L, DEC_BATCH, S5_GROUPS, S5_STATE), 0.1),
        "state_s5_im": nrm(ks[5], (L, DEC_BATCH, S5_GROUPS, S5_STATE), 0.1),
        "g_mix": 1.0 + nrm(ks[6], (L, D_MODEL), 0.01),
        "w_in": nrm(ks[7], (L, D_MODEL, IN_WIDTH), D_MODEL ** -0.5),
        "g_q": 1.0 + nrm(ks[8], (L, Q_LORA), 0.01),
        "w_uq": nrm(ks[9], (L, Q_LORA, MLA_HEADS * (QK_NOPE + QK_ROPE)), Q_LORA ** -0.5),
        "g_kv": 1.0 + nrm(ks[10], (L, KV_LORA), 0.01),
        "w_ukv": nrm(ks[11], (L, KV_LORA, MLA_HEADS * (QK_NOPE + V_HEAD)), KV_LORA ** -0.5),
        "s5_a_re": -0.5 + nrm(ks[12], (L, S5_GROUPS, S5_STATE), 0.01),
        "s5_a_im": math.pi * jnp.arange(S5_STATE, dtype=f32)[None, None, :] + nrm(ks[13], (L, S5_GROUPS, S5_STATE), 0.01),
        "s5_log_dt": jax.random.uniform(ks[14], (L, S5_GROUPS), f32, math.log(1e-3), math.log(1e-1)),
        "s5_b_re": nrm(ks[15], (L, S5_GROUPS, S5_STATE, S5_GROUP_CH), (2 * S5_GROUP_CH) ** -0.5),
        "s5_b_im": nrm(ks[16], (L, S5_GROUPS, S5_STATE, S5_GROUP_CH), (2 * S5_GROUP_CH) ** -0.5),
        "s5_c_re": nrm(ks[17], (L, S5_GROUPS, S5_GROUP_CH, S5_STATE), S5_STATE ** -0.5),
        "s5_c_im": nrm(ks[18], (L, S5_GROUPS, S5_GROUP_CH, S5_STATE), S5_STATE ** -0.5),
        "s5_d": nrm(ks[19], (L, S5_WIDTH), 1.0),
        "w_glu": nrm(ks[20], (L, S5_WIDTH, S5_WIDTH), S5_WIDTH ** -0.5),
        "b_glu": nrm(ks[21], (L, S5_WIDTH), 0.01),
        "g_out_mla": 1.0 + nrm(ks[22], (L, MLA_WIDTH), 0.01),
        "g_out_s5": 1.0 + nrm(ks[23], (L, S5_WIDTH), 0.01),
        "w_out": nrm(ks[24], (L, MIX_WIDTH, D_MODEL), MIX_WIDTH ** -0.5),
        "g_ffn": 1.0 + nrm(ks[25], (L, D_MODEL), 0.01),
        "w_gate": nrm(ks[26], (L, D_MODEL, D_FF), D_MODEL ** -0.5),
        "w_up": nrm(ks[27], (L, D_MODEL, D_FF), D_MODEL ** -0.5),
        "w_down": nrm(ks[28], (L, D_FF, D_MODEL), D_FF ** -0.5),
        "g_final": 1.0 + nrm(ks[29], (D_MODEL,), 0.01),
    }


def reference(x_prompt, x_sample, cache_mla_ckv, cache_mla_krope, state_s5_re, state_s5_im,
              g_mix, w_in, g_q, w_uq, g_kv, w_ukv,
              s5_a_re, s5_a_im, s5_log_dt, s5_b_re, s5_b_im, s5_c_re, s5_c_im, s5_d, w_glu, b_glu,
              g_out_mla, g_out_s5, w_out, g_ffn, w_gate, w_up, w_down, g_final):
    past_len = cache_mla_ckv.shape[2]
    p_pos = jnp.arange(x_prompt.shape[1])
    s_pos = past_len + jnp.arange(x_sample.shape[1])
    xp, xs = x_prompt, x_sample
    p_ckv, p_kr, p_re, p_im = [], [], [], []
    s_ckv, s_kr, s_re, s_im = [], [], [], []
    for l in range(DEPTH):
        lw = (g_mix[l], w_in[l], g_q[l], w_uq[l], g_kv[l], w_ukv[l],
              s5_a_re[l], s5_a_im[l], s5_log_dt[l], s5_b_re[l], s5_b_im[l], s5_c_re[l], s5_c_im[l],
              s5_d[l], w_glu[l], b_glu[l], g_out_mla[l], g_out_s5[l], w_out[l],
              g_ffn[l], w_gate[l], w_up[l], w_down[l])
        zeros = jnp.zeros((xp.shape[0], S5_GROUPS, S5_STATE), jnp.float32)
        xp, ck, kr, sr, si = _block(xp, p_pos, None, None, zeros, zeros, *lw)
        p_ckv.append(ck); p_kr.append(kr); p_re.append(sr); p_im.append(si)
        xs, ck, kr, sr, si = _block(xs, s_pos, cache_mla_ckv[l], cache_mla_krope[l],
                                    state_s5_re[l], state_s5_im[l], *lw)
        s_ckv.append(ck); s_kr.append(kr); s_re.append(sr); s_im.append(si)
    y_prompt = _rmsnorm(xp, g_final)
    y_sample = _rmsnorm(xs, g_final)
    return (y_prompt, y_sample,
            jnp.stack(p_ckv), jnp.stack(p_kr), jnp.stack(p_re), jnp.stack(p_im),
            jnp.stack(s_ckv), jnp.stack(s_kr), jnp.stack(s_re), jnp.stack(s_im))
```

```cpp
#include <hip/hip_runtime.h>
#include <hip/hip_cooperative_groups.h>
#include <cstdio>
#include <cstdint>
#include <hip/hip_runtime.h>
#include <cstdio>
#include <cstdint>
namespace pg8 {
#define PG8_LAS __attribute__((address_space(3)))
typedef unsigned short bf16_t;
typedef short bf16x8 __attribute__((ext_vector_type(8)));
typedef float f32x4 __attribute__((ext_vector_type(4)));
typedef unsigned u32x4 __attribute__((ext_vector_type(4)));
constexpr int BM = 256, BK = 64, HALF = 128, HTB = HALF * BK * 2  , STAGE_BYTES = 8 * HTB, NXCD = 8, WGM = 8;

__host__ __device__ __forceinline__ int lds_byte(int r, int c) { const int st = (r >> 4) * 2 + (c >> 5), rr = r & 15, cc = c & 31, ob = rr * 64 + cc * 2; return st * 1024 + (ob ^ (((ob >> 9) & 1) << 5)); }
__host__ __device__ __forceinline__ void stage_rc(int b, int& R, int& C) { const int st = b / 1024, sb = b % 1024, swz = sb ^ (((sb >> 9) & 1) << 5); R = (st >> 1) * 16 + swz / 64; C = (st & 1) * 32 + (swz % 64) / 2; }
__host__ __device__ __forceinline__ int perm32(int rho) { const int n = rho >> 4, i = rho & 15; return 8 * (i >> 2) + 4 * n + (i & 3); }

struct Unit { int pm, pn; };
struct Gemm { const bf16_t* A; const bf16_t* Bt; int M, N, K; };

struct StaticOrder {
    int nM, nN, nwg, G, c;
    __host__ __device__ void init(int M, int N, int G_, int c_) { nM = M / BM; nN = N / BM; nwg = nM * nN; G = G_; c = c_; }
    __host__ __device__ bool next(int i, Unit& u) const {
        const long L = (long)i * G + c; if (L >= nwg) return false;
        int wgid = (int)L; { const int q = nwg / NXCD, r = nwg % NXCD, xcd = wgid % NXCD, off = wgid / NXCD; wgid = (xcd < r ? xcd * (q + 1) : r * (q + 1) + (xcd - r) * q) + off; }
        const int nig = WGM * nN, gid = wgid / nig, fm = gid * WGM, gsz = (nM - fm) < WGM ? (nM - fm) : WGM;
        u.pm = fm + ((wgid % nig) % gsz); u.pn = (wgid % nig) / gsz; return true;
    }
    __device__ __forceinline__ void a_ready(const Unit&) const {}
    __device__ __forceinline__ void done(const Unit&) const {}
};

__device__ __forceinline__ unsigned cvt_pk_bf16(float lo, float hi) { unsigned r; asm volatile("v_cvt_pk_bf16_f32 %0, %1, %2" : "=v"(r) : "v"(lo), "v"(hi)); return r; }
typedef float f32x2 __attribute__((ext_vector_type(2)));
__device__ __forceinline__ f32x2 gelu_pk(f32x2 v) {
    const f32x2 av = __builtin_elementwise_abs(v), d = av * 0.2316418882f + 1.0f;
    f32x2 t; t.x = __builtin_amdgcn_rcpf(d.x); t.y = __builtin_amdgcn_rcpf(d.y);
    f32x2 q = t * 0.5307027145f + (-0.7265760135f); q = q * t + 0.7107068705f; q = q * t + (-0.142248368f); q = q * t + 0.127414796f; q = q * t;
    const f32x2 s = (v * v) * (-0.72134752044f);
    f32x2 e; e.x = __builtin_amdgcn_exp2f(s.x); e.y = __builtin_amdgcn_exp2f(s.y);
    const f32x2 m = v * (q * e), r = v - m;
    f32x2 o; o.x = v.x < 0.f ? m.x : r.x; o.y = v.y < 0.f ? m.y : r.y; return o;
}

template <int ACT  > struct EpiBf16 {
    static constexpr bool PERM = true, AFTER_DRAIN = false; static_assert(ACT == 0 || ACT == 1, "EpiBf16: ACT is 0 (none) or 1 (gelu_pk)");
    bf16_t* O; int ldc; const float* bias; int split_cols; size_t split_stride; float scale0;
    __device__ __forceinline__ void operator()(const f32x4 (&acc)[2][2][4][2], const Unit& u, int wr, int wc, int fr, int fq) const {
        const int row0 = u.pm * BM + wr * 64 + fr; int colt = u.pn * BM; bf16_t* base = O;
        float sc = 1.f; if (split_cols) { const int t = colt / split_cols; base += (size_t)t * split_stride; colt -= t * split_cols; if (t == 0) sc = scale0; }
        const int col0 = colt + wc * 32 + 8 * fq, bcol0 = u.pn * BM + wc * 32 + 8 * fq;
        f32x4 bv[2][2];
#pragma unroll
        for (int bj = 0; bj < 2; ++bj)
#pragma unroll
            for (int n = 0; n < 2; ++n) bv[bj][n] = bias ? *(const f32x4*)(bias + bcol0 + bj * HALF + 4 * n) : (f32x4){0.f, 0.f, 0.f, 0.f};
#pragma unroll
        for (int ai = 0; ai < 2; ++ai)
#pragma unroll
            for (int m = 0; m < 4; ++m) { bf16_t* rowp = base + (size_t)(row0 + ai * HALF + m * 16) * ldc + col0;
#pragma unroll
                for (int bj = 0; bj < 2; ++bj) { f32x4 v0 = acc[ai][bj][m][0] + bv[bj][0], v1 = acc[ai][bj][m][1] + bv[bj][1];
                    if (ACT == 1) { f32x2 a = gelu_pk((f32x2){v0[0], v0[1]}), b = gelu_pk((f32x2){v0[2], v0[3]}), c = gelu_pk((f32x2){v1[0], v1[1]}), d = gelu_pk((f32x2){v1[2], v1[3]});
                        v0 = (f32x4){a.x, a.y, b.x, b.y}; v1 = (f32x4){c.x, c.y, d.x, d.y}; }
                    v0 = v0 * sc; v1 = v1 * sc; u32x4 w; w.x = cvt_pk_bf16(v0[0], v0[1]); w.y = cvt_pk_bf16(v0[2], v0[3]); w.z = cvt_pk_bf16(v1[0], v1[1]); w.w = cvt_pk_bf16(v1[2], v1[3]);
                    *(u32x4*)(rowp + bj * HALF) = w; } }
    }
};
template <class Epi, class Sched, bool ALIGN_EPI = false, bool SP2 = false>
__device__ __forceinline__ void gemm_phase(PG8_LAS unsigned char* lds, const Gemm g, const Sched& S, const Epi& E) {
    const int tid = threadIdx.x, wid = __builtin_amdgcn_readfirstlane(tid >> 6), lane = tid & 63, wr = wid >> 2, wc = wid & 3, fr = lane & 15, fq = lane >> 4;
    const int K = g.K, nt = K / BK;
    unsigned voffA[2], voffB[2];
#pragma unroll
    for (int i = 0; i < 2; ++i) { int R, C; stage_rc(tid * 16 + i * 8192, R, C); const int Rb = Epi::PERM ? ((R & ~31) + perm32(R & 31)) : R;
        voffA[i] = (unsigned)(R * K + C) * 2u; voffB[i] = (unsigned)(Rb * K + C) * 2u; }
    const size_t kstep = (size_t)(BK * 2);
    const size_t hstep = (size_t)HALF * K * 2;
    const size_t tstep = 2 * hstep;
    const unsigned ldsw = (unsigned)wid * 1024u;
    const int aoff = lds_byte(wr * 64 + fr, fq * 8), boff = lds_byte(wc * 32 + fr, fq * 8);
#define PG8_SA(b, h) (((b) * 2 + (h)) * HTB)
#define PG8_SB(b, h) ((4 + (b) * 2 + (h)) * HTB)
#define PG8_STAGE(bufoff, gbase, voff) do { _Pragma("unroll") for (int _i = 0; _i < 2; ++_i) \
        __builtin_amdgcn_global_load_lds((const unsigned*)((const char*)(gbase) + (voff)[_i]), (PG8_LAS unsigned*)(lds + (bufoff) + ldsw + _i * 8192), 16, 0, 0); } while (0)
#define PG8_LDA(dst, b, h) do { _Pragma("unroll") for (int m = 0; m < 4; ++m) _Pragma("unroll") for (int k = 0; k < 2; ++k) dst[m][k] = *(const PG8_LAS bf16x8*)(lds + PG8_SA(b, h) + aoff + m * 2048 + k * 1024); } while (0)
#define PG8_LDB(dst, b, h) do { _Pragma("unroll") for (int n = 0; n < 2; ++n) _Pragma("unroll") for (int k = 0; k < 2; ++k) dst[n][k] = *(const PG8_LAS bf16x8*)(lds + PG8_SB(b, h) + boff + n * 2048 + k * 1024); } while (0)
#define PG8_MMA(ai, bj, At, Bt) do { __builtin_amdgcn_s_setprio(1); _Pragma("unroll") for (int m = 0; m < 4; ++m) _Pragma("unroll") for (int n = 0; n < 2; ++n) _Pragma("unroll") for (int k = 0; k < 2; ++k) \
        acc[ai][bj][m][n] = __builtin_amdgcn_mfma_f32_16x16x32_bf16(Bt[n][k], At[m][k], acc[ai][bj][m][n], 0, 0, 0); __builtin_amdgcn_s_setprio(0); } while (0)
#define PG8_WAIT_V(n) asm volatile("s_waitcnt vmcnt(" #n ")" ::: "memory")
#define PG8_WAIT_L(n) asm volatile("s_waitcnt lgkmcnt(" #n ")" ::: "memory")
#define PG8_BAR __builtin_amdgcn_s_barrier()
#define PG8_SCHED __builtin_amdgcn_sched_barrier(0)
    Unit cur, nxt; int ui = 0;
    if (!S.next(0, cur)) return;
    f32x4 acc[2][2][4][2];
#pragma unroll
    for (int a = 0; a < 2; ++a)
#pragma unroll
        for (int b = 0; b < 2; ++b)
#pragma unroll
            for (int m = 0; m < 4; ++m)
#pragma unroll
                for (int n = 0; n < 2; ++n) acc[a][b][m][n] = (f32x4){0.f, 0.f, 0.f, 0.f};
    bf16x8 At[4][2], B0[2][2], B1[2][2];
    const char* cA = (const char*)g.A + (size_t)cur.pm * tstep; const char* cB = (const char*)g.Bt + (size_t)cur.pn * tstep;
    S.a_ready(cur);
    if constexpr (SP2) {
        PG8_STAGE(PG8_SB(0, 0), cB, voffB); PG8_STAGE(PG8_SB(0, 1), cB + hstep, voffB); PG8_STAGE(PG8_SA(0, 0), cA, voffA); PG8_STAGE(PG8_SA(0, 1), cA + hstep, voffA);
        if (wr == 1) PG8_BAR;
        PG8_WAIT_V(2); PG8_BAR;
        PG8_STAGE(PG8_SB(1, 0), cB + kstep, voffB); PG8_STAGE(PG8_SA(1, 0), cA + kstep, voffA); PG8_STAGE(PG8_SB(1, 1), cB + hstep + kstep, voffB);
        PG8_WAIT_V(6); PG8_BAR;
    } else {
        PG8_STAGE(PG8_SB(0, 0), cB, voffB); PG8_STAGE(PG8_SA(0, 0), cA, voffA); PG8_STAGE(PG8_SB(0, 1), cB + hstep, voffB); PG8_STAGE(PG8_SA(0, 1), cA + hstep, voffA);
        if (wr == 1) PG8_BAR;
        PG8_WAIT_V(4); PG8_BAR;
        PG8_STAGE(PG8_SB(1, 0), cB + kstep, voffB); PG8_STAGE(PG8_SA(1, 0), cA + kstep, voffA); PG8_STAGE(PG8_SB(1, 1), cB + hstep + kstep, voffB);
        PG8_WAIT_V(6); PG8_BAR;
    }
    for (;;) {
        const bool has_next = S.next(ui + 1, nxt);
        const char* nA = has_next ? (const char*)g.A + (size_t)nxt.pm * tstep : cA; const char* nB = has_next ? (const char*)g.Bt + (size_t)nxt.pn * tstep : cB;
        for (int t = 0; t < nt; t += 2) {
            const bool last = (t == nt - 2);
            const char* a1 = cA + (size_t)(t + 1) * kstep;
            const char* a2 = last ? nA : cA + (size_t)(t + 2) * kstep; const char* b2 = last ? nB : cB + (size_t)(t + 2) * kstep;
            const char* a3 = a2 + kstep; const char* b3 = b2 + kstep;
            if (last && has_next) S.a_ready(nxt);
            if constexpr (SP2) {
            PG8_LDB(B0, 0, 0); PG8_LDB(B1, 0, 1); PG8_SCHED; PG8_LDA(At, 0, 0); PG8_STAGE(PG8_SA(1, 1), a1 + hstep, voffA);
            PG8_WAIT_V(8); PG8_WAIT_L(0); PG8_BAR; PG8_MMA(0, 0, At, B0); PG8_MMA(0, 1, At, B1); PG8_BAR; PG8_SCHED;
            PG8_LDA(At, 0, 1); PG8_STAGE(PG8_SB(0, 0), b2, voffB); PG8_STAGE(PG8_SB(0, 1), b2 + hstep, voffB); PG8_STAGE(PG8_SA(0, 0), a2, voffA);
            PG8_WAIT_V(8); PG8_WAIT_L(0); PG8_BAR; PG8_MMA(1, 0, At, B0); PG8_MMA(1, 1, At, B1); PG8_BAR; PG8_SCHED;
            PG8_LDB(B0, 1, 0); PG8_LDB(B1, 1, 1); PG8_SCHED; PG8_LDA(At, 1, 0); PG8_STAGE(PG8_SA(0, 1), a2 + hstep, voffA);
            PG8_WAIT_V(8); PG8_WAIT_L(0); PG8_BAR; PG8_MMA(0, 0, At, B0); PG8_MMA(0, 1, At, B1); PG8_BAR; PG8_SCHED;
            PG8_LDA(At, 1, 1); PG8_STAGE(PG8_SB(1, 0), b3, voffB); PG8_STAGE(PG8_SB(1, 1), b3 + hstep, voffB); PG8_STAGE(PG8_SA(1, 0), a3, voffA);
            PG8_WAIT_V(8); PG8_WAIT_L(0); PG8_BAR; PG8_MMA(1, 0, At, B0); PG8_MMA(1, 1, At, B1); PG8_BAR; PG8_SCHED;
            } else {
            PG8_LDB(B0, 0, 0); PG8_SCHED; PG8_LDA(At, 0, 0); PG8_STAGE(PG8_SA(1, 1), a1 + hstep, voffA);
            PG8_WAIT_L(8); PG8_BAR; PG8_WAIT_L(0); PG8_MMA(0, 0, At, B0); PG8_BAR; PG8_SCHED;
            PG8_LDB(B1, 0, 1); PG8_STAGE(PG8_SB(0, 0), b2, voffB);
            PG8_BAR; PG8_WAIT_L(0); PG8_MMA(0, 1, At, B1); PG8_BAR;
            PG8_LDA(At, 0, 1); PG8_STAGE(PG8_SA(0, 0), a2, voffA);
            PG8_BAR; PG8_WAIT_L(0); PG8_MMA(1, 0, At, B0); PG8_BAR; PG8_SCHED;
            PG8_STAGE(PG8_SB(0, 1), b2 + hstep, voffB);
            PG8_WAIT_V(6); PG8_BAR; PG8_MMA(1, 1, At, B1); PG8_BAR;
            PG8_LDB(B0, 1, 0); PG8_SCHED; PG8_LDA(At, 1, 0); PG8_STAGE(PG8_SA(0, 1), a2 + hstep, voffA);
            PG8_WAIT_L(8); PG8_BAR; PG8_WAIT_L(0); PG8_MMA(0, 0, At, B0); PG8_BAR; PG8_SCHED;
            PG8_LDB(B1, 1, 1); PG8_STAGE(PG8_SB(1, 0), b3, voffB);
            PG8_BAR; PG8_WAIT_L(0); PG8_MMA(0, 1, At, B1); PG8_BAR;
            PG8_LDA(At, 1, 1); PG8_STAGE(PG8_SA(1, 0), a3, voffA);
            PG8_BAR; PG8_WAIT_L(0); PG8_MMA(1, 0, At, B0); PG8_BAR; PG8_SCHED;
            PG8_STAGE(PG8_SB(1, 1), b3 + hstep, voffB);
            PG8_WAIT_V(6); PG8_BAR; PG8_MMA(1, 1, At, B1); PG8_BAR;
            }
        }
        if constexpr (ALIGN_EPI) { if (wr == 0) PG8_BAR; }
        if constexpr (!Epi::AFTER_DRAIN) { E(acc, cur, wr, wc, fr, fq); S.done(cur); }
        if (!has_next) break;
#pragma unroll
        for (int a = 0; a < 2; ++a)
#pragma unroll
            for (int b = 0; b < 2; ++b)
#pragma unroll
                for (int m = 0; m < 4; ++m)
#pragma unroll
                    for (int n = 0; n < 2; ++n) acc[a][b][m][n] = (f32x4){0.f, 0.f, 0.f, 0.f};
        cur = nxt; cA = nA; cB = nB; ++ui;
        if constexpr (ALIGN_EPI) { if (wr == 1) PG8_BAR; }
    }
    PG8_WAIT_V(0);
    if constexpr (!ALIGN_EPI) { if (wr == 0) PG8_BAR; }
    PG8_BAR;
    if constexpr (Epi::AFTER_DRAIN) { E.fused(acc, cur, wr, wc, fr, fq, lds, wid, lane); S.done(cur); }
#undef PG8_SA
#undef PG8_SB
#undef PG8_STAGE
#undef PG8_LDA
#undef PG8_LDB
#undef PG8_MMA
#undef PG8_WAIT_V
#undef PG8_WAIT_L
#undef PG8_BAR
#undef PG8_SCHED
}
}

namespace cg = cooperative_groups;
#define LAS __attribute__((address_space(3)))
typedef unsigned short bf16;
typedef float f32x4 __attribute__((ext_vector_type(4)));
typedef float f32x2 __attribute__((ext_vector_type(2)));
typedef float f32x16 __attribute__((ext_vector_type(16)));
typedef unsigned u32x4 __attribute__((ext_vector_type(4)));
typedef unsigned u32x2 __attribute__((ext_vector_type(2)));
typedef short bf16x8 __attribute__((ext_vector_type(8)));

#ifndef ONE_LAUNCH
#define ONE_LAUNCH 1
#endif

constexpr int NTHR = 512;
constexpr int DM = 1024, NP = 65536, NSAMP = 1024, MR = NP + NSAMP  , MKV = NP + NSAMP + 65536  ;
constexpr int SEQ = 2048, DECS = 32, PAST = 2048;
constexpr int QLORA = 384, KVL = 256, ROPE = 32, S5W = 512, INW = 1184, DFF = 2816;
constexpr int NCH = 2080;
constexpr int NCHP = 2176;
constexpr float EPS = 1e-6f;
constexpr float QSCALE = 0.10206207261596577f * 1.4426950408889634f;

constexpr size_t O_Y = 0, O_PCKV = 68157440, O_PKR = 84934656, O_PRE = 87031808, O_PIM = 87097344, O_SCKV = 87162880, O_SKR = 87425024, O_SRE = 87457792, O_SIM = 87523328;

constexpr size_t MiB = 1u << 20;
constexpr size_t WS_SSQQ = 0, WS_SSQF = MiB / 2, WS_RSX = MiB, WS_ROPE = MiB * 3 / 2, WS_PW = 2 * MiB, WS_BBAR = 3 * MiB, WS_KG = MiB * 7 / 2;
constexpr size_t WS_WIN = 5 * MiB, WS_WUQ = 8 * MiB, WS_WUK = MiB * 35 / 4, WS_WUV = 9 * MiB, WS_WGLU = MiB * 19 / 2, WS_WOUT = 10 * MiB, WS_WGU = 12 * MiB, WS_WDN = 23 * MiB;
constexpr size_t WS_WST = 29 * MiB, WS_W2 = 33 * MiB;
constexpr size_t WS_MIX = 64 * MiB, WS_XB = 194 * MiB, WS_U2 = 324 * MiB, WS_CKVRAW = 390 * MiB, WS_CQ = 423 * MiB, WS_Q = 472 * MiB, WS_CKVALL = 570 * MiB, WS_KR = 635 * MiB;
constexpr size_t WS_KN = 644 * MiB, WS_VT = 773 * MiB, WS_Z = 902 * MiB, WS_S = 967 * MiB, WS_XPREV = 1001 * MiB, WS_END = 1018 * MiB;
constexpr size_t WS_HID = 324 * MiB, WS_X1B = WS_XB;

struct Args {
    const float* in[30];
    float* out; unsigned char* ws;
    int ph_lo, ph_hi;
};
typedef const __attribute__((address_space(4))) Args* ArgsP;

__device__ __forceinline__ float bf2f(unsigned short b) { return __uint_as_float((unsigned)b << 16); }
__device__ __forceinline__ unsigned pk2(float lo, float hi) { return pg8::cvt_pk_bf16(lo, hi); }
__device__ __forceinline__ u32x4 pack8(f32x4 a, f32x4 b) { u32x4 w; w.x = pk2(a[0], a[1]); w.y = pk2(a[2], a[3]); w.z = pk2(b[0], b[1]); w.w = pk2(b[2], b[3]); return w; }
__device__ __forceinline__ u32x2 pack4(f32x4 a) { u32x2 w; w.x = pk2(a[0], a[1]); w.y = pk2(a[2], a[3]); return w; }
__device__ __forceinline__ float sumsq4(f32x4 a) { return (a[0] * a[0] + a[1] * a[1]) + (a[2] * a[2] + a[3] * a[3]); }
__device__ __forceinline__ float wave_sum(float v) {
#pragma unroll
    for (int o = 1; o < 64; o <<= 1) v += __shfl_xor(v, o);
    return v;
}
__device__ __forceinline__ float fast_sigmoid(float v) { return __builtin_amdgcn_rcpf(1.0f + __expf(-v)); }

using pg8::Unit;
#define EPI_HDR static constexpr bool PERM = true, AFTER_DRAIN = false;
#define EPI_ARGS const f32x4 (&acc)[2][2][4][2], const Unit& u, int wr, int wc, int fr, int fq

struct EpiG1 {
    EPI_HDR
    bf16* CKVraw; bf16* CQ; bf16* U2; float* ssq_q; const float* rs_x; const float* rope; float* out; bf16* KR;
    __device__ __forceinline__ void operator()(EPI_ARGS) const {
        const int pn = u.pn;
#pragma unroll
        for (int ai = 0; ai < 2; ++ai)
#pragma unroll
            for (int m = 0; m < 4; ++m) {
                const int row = u.pm * 256 + ai * 128 + wr * 64 + m * 16 + fr;
                const float rs = rs_x[row];
                float ss = 0.f;
#pragma unroll
                for (int bj = 0; bj < 2; ++bj) {
                    const f32x4 v0 = acc[ai][bj][m][0] * rs, v1 = acc[ai][bj][m][1] * rs;
                    const int cl = bj * 128 + wc * 32 + 8 * fq;
                    if (pn == 0) { *(u32x4*)(CKVraw + (size_t)row * 256 + cl) = pack8(v0, v1); }
                    else if (pn == 1) { *(u32x4*)(CQ + (size_t)row * 384 + cl) = pack8(v0, v1); ss += sumsq4(v0) + sumsq4(v1); }
                    else if (pn == 2) {
                        if (bj == 0) { *(u32x4*)(CQ + (size_t)row * 384 + 256 + cl) = pack8(v0, v1); ss += sumsq4(v0) + sumsq4(v1); }
                        else if (wc == 0) {
                            const int pos = row < NP ? (row & (SEQ - 1)) : PAST + ((row - NP) & (DECS - 1));
                            const f32x4 c4 = *(const f32x4*)(rope + pos * 32 + 4 * fq), s4 = *(const f32x4*)(rope + pos * 32 + 16 + 4 * fq);
                            const f32x4 o1 = v0 * c4 - v1 * s4, o2 = v1 * c4 + v0 * s4;
                            float* dst = row < NP ? out + O_PKR + (size_t)row * 32 : out + O_SKR + (size_t)(row - NP) * 32;
                            *(f32x4*)(dst + 4 * fq) = o1; *(f32x4*)(dst + 16 + 4 * fq) = o2;
                            *(u32x2*)(KR + (size_t)row * 32 + 4 * fq) = pack4(o1); *(u32x2*)(KR + (size_t)row * 32 + 16 + 4 * fq) = pack4(o2);
                        }
                    } else {
                        const int c = (pn - 3) * 256 + cl, g = c >> 4;
                        *(u32x4*)(U2 + ((size_t)g * MR + row) * 16 + (c & 15)) = pack8(v0, v1);
                    }
                }
                if (pn == 1 || pn == 2) { ss += __shfl_xor(ss, 16); ss += __shfl_xor(ss, 32); if (fq == 0) atomicAdd(ssq_q + row, ss); }
                asm volatile("" ::: "memory");
            }
    }
};

struct EpiG2 {
    EPI_HDR
    bf16* Q; const float* ssq_q; const float* rope;
    __device__ __forceinline__ void operator()(EPI_ARGS) const {
        const int pn = u.pn;
#pragma unroll
        for (int ai = 0; ai < 2; ++ai)
#pragma unroll
            for (int m = 0; m < 4; ++m) {
                const int row = u.pm * 256 + ai * 128 + wr * 64 + m * 16 + fr;
                const float rs = rsqrtf(ssq_q[row] * (1.0f / QLORA) + EPS);
                const int pos = row < NP ? (row & (SEQ - 1)) : PAST + ((row - NP) & (DECS - 1));
#pragma unroll
                for (int bj = 0; bj < 2; ++bj) {
                    const f32x4 v0 = acc[ai][bj][m][0] * rs, v1 = acc[ai][bj][m][1] * rs;
                    if (pn < 2) { *(u32x4*)(Q + (size_t)row * 768 + pn * 256 + bj * 128 + wc * 32 + 8 * fq) = pack8(v0, v1); }
                    else {
                        const int head = bj * 4 + wc;
                        const f32x4 c4 = *(const f32x4*)(rope + pos * 32 + 4 * fq), s4 = *(const f32x4*)(rope + pos * 32 + 16 + 4 * fq);
                        const f32x4 o1 = v0 * c4 - v1 * s4, o2 = v1 * c4 + v0 * s4;
                        *(u32x2*)(Q + (size_t)row * 768 + 512 + head * 32 + 4 * fq) = pack4(o1);
                        *(u32x2*)(Q + (size_t)row * 768 + 512 + head * 32 + 16 + 4 * fq) = pack4(o2);
                    }
                }
                asm volatile("" ::: "memory");
            }
    }
};

struct EpiGLU {
    EPI_HDR
    const bf16* Z; const float* bias; bf16* MIX;
    __device__ __forceinline__ void operator()(EPI_ARGS) const {
#pragma unroll
        for (int bj = 0; bj < 2; ++bj) {
            const int col = u.pn * 256 + bj * 128 + wc * 32 + 8 * fq;
            const f32x4 b0 = *(const f32x4*)(bias + col), b1 = *(const f32x4*)(bias + col + 4);
#pragma unroll
            for (int ai = 0; ai < 2; ++ai)
#pragma unroll
                for (int m = 0; m < 4; ++m) {
                    const int row = u.pm * 256 + ai * 128 + wr * 64 + m * 16 + fr;
                    const u32x4 zz = *(const u32x4*)(Z + (size_t)row * 512 + col);
                    f32x4 z0, z1;
                    z0[0] = __uint_as_float(zz.x << 16); z0[1] = __uint_as_float(zz.x & 0xffff0000u); z0[2] = __uint_as_float(zz.y << 16); z0[3] = __uint_as_float(zz.y & 0xffff0000u);
                    z1[0] = __uint_as_float(zz.z << 16); z1[1] = __uint_as_float(zz.z & 0xffff0000u); z1[2] = __uint_as_float(zz.w << 16); z1[3] = __uint_as_float(zz.w & 0xffff0000u);
                    const f32x4 a0 = acc[ai][bj][m][0] + b0, a1 = acc[ai][bj][m][1] + b1;
                    f32x4 o0, o1;
#pragma unroll
                    for (int i = 0; i < 4; ++i) { o0[i] = z0[i] * fast_sigmoid(a0[i]); o1[i] = z1[i] * fast_sigmoid(a1[i]); }
                    *(u32x4*)(MIX + (size_t)row * 1024 + 512 + col) = pack8(o0, o1);
                    asm volatile("" ::: "memory");
                }
        }
    }
};

struct EpiOut {
    EPI_HDR
    const float* xp; const float* xs; float* Y; bf16* X1B; float* ssq_f;
    __device__ __forceinline__ void operator()(EPI_ARGS) const {
#pragma unroll
        for (int ai = 0; ai < 2; ++ai)
#pragma unroll
            for (int m = 0; m < 4; ++m) {
                const int row = u.pm * 256 + ai * 128 + wr * 64 + m * 16 + fr;
                const float* xsrc = row < NP ? xp + (size_t)row * DM : xs + (size_t)(row - NP) * DM;
                float ss = 0.f;
#pragma unroll
                for (int bj = 0; bj < 2; ++bj) {
                    const int col = u.pn * 256 + bj * 128 + wc * 32 + 8 * fq;
                    const f32x4 y0 = *(const f32x4*)(xsrc + col) + acc[ai][bj][m][0], y1 = *(const f32x4*)(xsrc + col + 4) + acc[ai][bj][m][1];
                    *(f32x4*)(Y + (size_t)row * DM + col) = y0; *(f32x4*)(Y + (size_t)row * DM + col + 4) = y1;
                    *(u32x4*)(X1B + (size_t)row * DM + col) = pack8(y0, y1);
                    ss += sumsq4(y0) + sumsq4(y1);
                }
                ss += __shfl_xor(ss, 16); ss += __shfl_xor(ss, 32);
                if (fq == 0) atomicAdd(ssq_f + row, ss);
                asm volatile("" ::: "memory");
            }
    }
};

struct EpiGU {
    EPI_HDR
    bf16* HID; const float* ssq_f;
    __device__ __forceinline__ void operator()(EPI_ARGS) const {
#pragma unroll
        for (int ai = 0; ai < 2; ++ai)
#pragma unroll
            for (int m = 0; m < 4; ++m) {
                const int row = u.pm * 256 + ai * 128 + wr * 64 + m * 16 + fr;
                const float rs = rsqrtf(ssq_f[row] * (1.0f / DM) + EPS);
                f32x4 o[2];
#pragma unroll
                for (int n = 0; n < 2; ++n) {
                    const f32x4 g = acc[ai][0][m][n] * rs, uu = acc[ai][1][m][n] * rs;
#pragma unroll
                    for (int i = 0; i < 4; ++i) o[n][i] = g[i] * fast_sigmoid(g[i]) * uu[i];
                }
                *(u32x4*)(HID + (size_t)row * DFF + u.pn * 128 + wc * 32 + 8 * fq) = pack8(o[0], o[1]);
                asm volatile("" ::: "memory");
            }
    }
};

struct EpiDown {
    EPI_HDR
    float* Y;
    __device__ __forceinline__ void operator()(EPI_ARGS) const {
#pragma unroll
        for (int ai = 0; ai < 2; ++ai)
#pragma unroll
            for (int m = 0; m < 4; ++m) {
                const int row = u.pm * 256 + ai * 128 + wr * 64 + m * 16 + fr;
#pragma unroll
                for (int bj = 0; bj < 2; ++bj) {
                    float* p = Y + (size_t)row * DM + u.pn * 256 + bj * 128 + wc * 32 + 8 * fq;
                    const f32x4 y0 = *(const f32x4*)p + acc[ai][bj][m][0], y1 = *(const f32x4*)(p + 4) + acc[ai][bj][m][1];
                    *(f32x4*)p = y0; *(f32x4*)(p + 4) = y1;
                }
                asm volatile("" ::: "memory");
            }
    }
};

enum WKind { WK_IN = 0, WK_UQ, WK_UK, WK_UV, WK_PLAIN, WK_GU };
__device__ __forceinline__ int wsrc_col(int kind, int n) {
    switch (kind) {
    case WK_IN:
        if (n < 256) return 384 + n;
        if (n < 640) return n - 256;
        if (n < 672) { const int j = n - 640, fq = j >> 3, nn = (j >> 2) & 1, i = j & 3; return 640 + 16 * nn + 4 * fq + i; }
        if (n < 768) return -1;
        return 672 + (n - 768);
    case WK_UQ:
        if (n < 512) return (n >> 6) * 96 + (n & 63);
        { const int j = n - 512, h = j >> 5, jj = j & 31, fq = jj >> 3, nn = (jj >> 2) & 1, i = jj & 3; return h * 96 + 64 + 16 * nn + 4 * fq + i; }
    case WK_UK: return (n >> 6) * 128 + (n & 63);
    case WK_UV: return (n >> 6) * 128 + 64 + (n & 63);
    default: return n;
    }
}
__device__ __forceinline__ void conv_weight(bf16* dst, int N, int K, const float* W, const float* W2nd, int Nsrc, int kind, const float* sc0, const float* sc1, int sc_split, float mul, int gtid, int gthreads) {
    const int total = N * (K / 8);
    for (int idx = gtid; idx < total; idx += gthreads) {
        const int n = idx % N, k0 = (idx / N) * 8;
        const float* src = W; int sc;
        if (kind == WK_GU) { const int t = n >> 8, r = n & 255; sc = t * 128 + (r & 127); if (r >= 128) src = W2nd; }
        else sc = wsrc_col(kind, n);
        float v[8];
#pragma unroll
        for (int i = 0; i < 8; ++i) {
            const int k = k0 + i;
            float s = mul;
            if (sc0) s *= (k < sc_split) ? sc0[k] : sc1[k - sc_split];
            v[i] = sc >= 0 ? src[(size_t)k * Nsrc + sc] * s : 0.f;
        }
        u32x4 w; w.x = pk2(v[0], v[1]); w.y = pk2(v[2], v[3]); w.z = pk2(v[4], v[5]); w.w = pk2(v[6], v[7]);
        *(u32x4*)(dst + (size_t)n * K + k0) = w;
    }
}

__device__ __forceinline__ void phase0(ArgsP a, int gtid, int gthreads, int gw, int ngw, int lane) {
    unsigned char* ws = a->ws;
    { float* zq = (float*)(ws + WS_SSQQ); float* zf = (float*)(ws + WS_SSQF); for (int i = gtid; i < MR; i += gthreads) { zq[i] = 0.f; zf[i] = 0.f; } }
    { bf16* XB = (bf16*)(ws + WS_XB); float* rsx = (float*)(ws + WS_RSX);
      for (int row = gw; row < MR; row += ngw) {
          const float* src = row < NP ? a->in[0] + (size_t)row * DM : a->in[1] + (size_t)(row - NP) * DM;
          f32x4 v[4]; float s = 0.f;
#pragma unroll
          for (int j = 0; j < 4; ++j) { v[j] = *(const f32x4*)(src + 4 * lane + 256 * j); s += sumsq4(v[j]); }
          s = wave_sum(s);
          if (lane == 0) rsx[row] = rsqrtf(s * (1.0f / DM) + EPS);
#pragma unroll
          for (int j = 0; j < 4; ++j) *(u32x2*)(XB + (size_t)row * DM + 4 * lane + 256 * j) = pack4(v[j]);
      } }
    conv_weight((bf16*)(ws + WS_WIN), 1280, 1024, a->in[7], nullptr, INW, WK_IN, a->in[6], a->in[6], 1 << 30, 1.f, gtid, gthreads);
    conv_weight((bf16*)(ws + WS_WUQ), 768, 384, a->in[9], nullptr, 768, WK_UQ, a->in[8], a->in[8], 1 << 30, QSCALE, gtid, gthreads);
    conv_weight((bf16*)(ws + WS_WUK), 512, 256, a->in[11], nullptr, 1024, WK_UK, nullptr, nullptr, 0, 1.f, gtid, gthreads);
    conv_weight((bf16*)(ws + WS_WUV), 512, 256, a->in[11], nullptr, 1024, WK_UV, nullptr, nullptr, 0, 1.f, gtid, gthreads);
    conv_weight((bf16*)(ws + WS_WGLU), 512, 512, a->in[20], nullptr, 512, WK_PLAIN, nullptr, nullptr, 0, 1.f, gtid, gthreads);
    conv_weight((bf16*)(ws + WS_WOUT), 1024, 1024, a->in[24], nullptr, 1024, WK_PLAIN, a->in[22], a->in[23], 512, 1.f, gtid, gthreads);
    conv_weight((bf16*)(ws + WS_WGU), 5632, 1024, a->in[26], a->in[27], DFF, WK_GU, a->in[25], a->in[25], 1 << 30, 1.f, gtid, gthreads);
    conv_weight((bf16*)(ws + WS_WDN), 1024, DFF, a->in[28], nullptr, 1024, WK_PLAIN, nullptr, nullptr, 0, 1.f, gtid, gthreads);
    { float* rt = (float*)(ws + WS_ROPE);
      for (int idx = gtid; idx < (PAST + DECS) * 16; idx += gthreads) {
          const int pos = idx >> 4, i = idx & 15;
          const float inv = 1.0f / powf(10000.0f, (float)(2 * i) / 32.0f);
          const float ang = (float)pos * inv;
          rt[pos * 32 + i] = (float)cos((double)ang); rt[pos * 32 + 16 + i] = (float)sin((double)ang);
      } }
    { bf16* CK = (bf16*)(ws + WS_CKVALL) + (size_t)MR * 256; const float* src = a->in[2];
      for (int idx = gtid; idx < 65536 * 256 / 8; idx += gthreads) { const f32x4 v0 = *(const f32x4*)(src + (size_t)idx * 8), v1 = *(const f32x4*)(src + (size_t)idx * 8 + 4); *(u32x4*)(CK + (size_t)idx * 8) = pack8(v0, v1); }
      bf16* KRp = (bf16*)(ws + WS_KR) + (size_t)MR * 32; const float* s2 = a->in[3];
      for (int idx = gtid; idx < 65536 * 32 / 8; idx += gthreads) { const f32x4 v0 = *(const f32x4*)(s2 + (size_t)idx * 8), v1 = *(const f32x4*)(s2 + (size_t)idx * 8 + 4); *(u32x4*)(KRp + (size_t)idx * 8) = pack8(v0, v1); } }
    { f32x2* pw = (f32x2*)(ws + WS_PW); f32x2* bb = (f32x2*)(ws + WS_BBAR);
      for (int idx = gtid; idx < 32 * 64; idx += gthreads) {
          const int g = idx >> 6, p = idx & 63;
          const double dt = exp((double)a->in[14][g]), lr = (double)a->in[12][idx], li = (double)a->in[13][idx];
          for (int k = 0; k <= 32; ++k) { const double mag = exp(lr * dt * k), ang = li * dt * k; pw[(g * 33 + k) * 64 + p] = (f32x2){(float)(mag * cos(ang)), (float)(mag * sin(ang))}; }
          const double mag = exp(lr * dt), ang = li * dt, abr = mag * cos(ang), abi = mag * sin(ang), den = lr * lr + li * li;
          const double ur = abr - 1.0, ui = abi, vr = lr / den, vi = -li / den;
          const double zr = ur * vr - ui * vi, zi = ur * vi + ui * vr;
          for (int c = 0; c < 16; ++c) { const double br = (double)a->in[15][idx * 16 + c], bi = (double)a->in[16][idx * 16 + c]; bb[idx * 16 + c] = (f32x2){(float)(zr * br - zi * bi), (float)(zr * bi + zi * br)}; }
      } }
}

__device__ __forceinline__ void phase1_tables(ArgsP a, int gtid, int gthreads) {
    unsigned char* ws = a->ws;
    const f32x2* pw = (const f32x2*)(ws + WS_PW); const f32x2* bb = (const f32x2*)(ws + WS_BBAR);
    float* Kg = (float*)(ws + WS_KG);
    for (int idx = gtid; idx < 32 * 32 * 256; idx += gthreads) {
        const int g = idx >> 13, d = (idx >> 8) & 31, c = (idx >> 4) & 15, cp = idx & 15;
        float s = 0.f;
        for (int p = 0; p < 64; ++p) {
            const float cr = a->in[17][(g * 16 + c) * 64 + p], ci = a->in[18][(g * 16 + c) * 64 + p];
            const f32x2 w = pw[(g * 33 + d) * 64 + p], b = bb[(g * 64 + p) * 16 + cp];
            const float tr = w.x * b.x - w.y * b.y, ti = w.x * b.y + w.y * b.x;
            s += cr * tr - ci * ti;
        }
        Kg[idx] = s;
    }
    bf16* Wst = (bf16*)(ws + WS_WST);
    for (int idx = gtid; idx < 32 * 128 * 64; idx += gthreads) {
        const int g = idx >> 13, n = (idx >> 6) & 127, k0 = (idx & 63) * 8, s = k0 >> 4, c0 = k0 & 15, p = n & 63;
        const f32x2 w = pw[(g * 33 + (31 - s)) * 64 + p];
        float v[8];
#pragma unroll
        for (int i = 0; i < 8; ++i) { const f32x2 b = bb[(g * 64 + p) * 16 + c0 + i]; v[i] = n < 64 ? (w.x * b.x - w.y * b.y) : (w.x * b.y + w.y * b.x); }
        u32x4 o; o.x = pk2(v[0], v[1]); o.y = pk2(v[2], v[3]); o.z = pk2(v[4], v[5]); o.w = pk2(v[6], v[7]);
        *(u32x4*)(Wst + (size_t)idx * 8) = o;
    }
}
__device__ __forceinline__ void phase2_tables(ArgsP a, int gtid, int gthreads) {
    unsigned char* ws = a->ws;
    const f32x2* pw = (const f32x2*)(ws + WS_PW); const float* Kg = (const float*)(ws + WS_KG);
    bf16* W2 = (bf16*)(ws + WS_W2);
    for (int idx = gtid; idx < 32 * 512 * 80; idx += gthreads) {
        const int g = idx / (512 * 80), rem = idx - g * 512 * 80, n = rem / 80, k0 = (rem - n * 80) * 8, t = n >> 4, c = n & 15;
        float v[8];
        if (k0 < 512) {
            const int s = k0 >> 4, c0 = k0 & 15;
#pragma unroll
            for (int i = 0; i < 8; ++i) {
                float x = 0.f;
                if (s <= t) { x = Kg[((g * 32 + (t - s)) * 16 + c) * 16 + c0 + i]; if (s == t && c0 + i == c) x += a->in[19][g * 16 + c]; }
                v[i] = x;
            }
        } else {
            const int part = (k0 - 512) >> 6, p0 = (k0 - 512) & 63;
#pragma unroll
            for (int i = 0; i < 8; ++i) {
                const int p = p0 + i;
                const float cr = a->in[17][(g * 16 + c) * 64 + p], ci = a->in[18][(g * 16 + c) * 64 + p];
                const f32x2 w = pw[(g * 33 + t + 1) * 64 + p];
                v[i] = part == 0 ? (cr * w.x - ci * w.y) : -(cr * w.y + ci * w.x);
            }
        }
        u32x4 o; o.x = pk2(v[0], v[1]); o.y = pk2(v[2], v[3]); o.z = pk2(v[4], v[5]); o.w = pk2(v[6], v[7]);
        *(u32x4*)(W2 + (size_t)idx * 8) = o;
    }
}
__device__ __forceinline__ void phase2_ckv(ArgsP a, int gw, int ngw, int lane) {
    unsigned char* ws = a->ws;
    const bf16* raw = (const bf16*)(ws + WS_CKVRAW); bf16* CK = (bf16*)(ws + WS_CKVALL);
    const f32x4 g4 = *(const f32x4*)(a->in[10] + 4 * lane);
    for (int row = gw; row < MR; row += ngw) {
        const u32x2 r = *(const u32x2*)(raw + (size_t)row * 256 + 4 * lane);
        f32x4 v; v[0] = __uint_as_float(r.x << 16); v[1] = __uint_as_float(r.x & 0xffff0000u); v[2] = __uint_as_float(r.y << 16); v[3] = __uint_as_float(r.y & 0xffff0000u);
        const float s = wave_sum(sumsq4(v));
        const float rs = rsqrtf(s * (1.0f / KVL) + EPS);
        const f32x4 o = v * rs * g4;
        float* dst = row < NP ? a->out + O_PCKV + (size_t)row * 256 : a->out + O_SCKV + (size_t)(row - NP) * 256;
        *(f32x4*)(dst + 4 * lane) = o;
        *(u32x2*)(CK + (size_t)row * 256 + 4 * lane) = pack4(o);
    }
}

constexpr int SG_PITCH = 144, SG_TILE = 128 * SG_PITCH;
template <class Epi>
__device__ __forceinline__ void sgemm_unit(LAS unsigned char* lds, const bf16* A0, int lda0, int nkt0, const bf16* A1, int lda1, int nkt1, int boff1, const bf16* Bt, int ldb, const Epi& E) {
    const int tid = threadIdx.x, lane = tid & 63, wid = tid >> 6, wm = wid >> 2, wn = wid & 3, r32 = lane & 31, hi = lane >> 5;
    const int nkt = nkt0 + nkt1;
    f32x16 acc0 = {}, acc1 = {};
    u32x4 ra[2], rb[2];
    auto gload = [&](int kt) {
#pragma unroll
        for (int i = 0; i < 2; ++i) {
            const int c = tid + 512 * i, row = c >> 3, kc = c & 7;
            const bf16* ap = kt < nkt0 ? A0 + (size_t)row * lda0 + kt * 64 + kc * 8 : A1 + (size_t)row * lda1 + (kt - nkt0) * 64 + kc * 8;
            ra[i] = *(const u32x4*)ap;
            const int bc = kt < nkt0 ? kt * 64 : boff1 + (kt - nkt0) * 64;
            rb[i] = *(const u32x4*)(Bt + (size_t)row * ldb + bc + kc * 8);
        }
    };
    gload(0);
    for (int kt = 0; kt < nkt; ++kt) {
        __syncthreads();
#pragma unroll
        for (int i = 0; i < 2; ++i) { const int c = tid + 512 * i, row = c >> 3, kc = c & 7; *(LAS u32x4*)(lds + row * SG_PITCH + kc * 16) = ra[i]; *(LAS u32x4*)(lds + SG_TILE + row * SG_PITCH + kc * 16) = rb[i]; }
        __syncthreads();
        if (kt + 1 < nkt) gload(kt + 1);
#pragma unroll
        for (int j = 0; j < 4; ++j) {
            const bf16x8 a0 = *(const LAS bf16x8*)(lds + (64 * wm + r32) * SG_PITCH + (16 * j + 8 * hi) * 2);
            const bf16x8 a1 = *(const LAS bf16x8*)(lds + (64 * wm + 32 + r32) * SG_PITCH + (16 * j + 8 * hi) * 2);
            const bf16x8 b = *(const LAS bf16x8*)(lds + SG_TILE + (32 * wn + r32) * SG_PITCH + (16 * j + 8 * hi) * 2);
            acc0 = __builtin_amdgcn_mfma_f32_32x32x16_bf16(a0, b, acc0, 0, 0, 0);
            acc1 = __builtin_amdgcn_mfma_f32_32x32x16_bf16(a1, b, acc1, 0, 0, 0);
        }
    }
#pragma unroll
    for (int r = 0; r < 16; ++r) { const int mm = 64 * wm + (r & 3) + 8 * (r >> 2) + 4 * hi; E(mm, 32 * wn + r32, acc0[r]); E(mm + 32, 32 * wn + r32, acc1[r]); }
}
struct SEpiA { float* S; int m0, g; __device__ __forceinline__ void operator()(int mm, int n, float v) const { const int m = m0 + mm; if (m < NCH) S[((size_t)m * 32 + g) * 128 + n] = v; } };
struct SEpiB { bf16* Z; int m0, n0, g;
    __device__ __forceinline__ void operator()(int mm, int nn, float y) const {
        const int m = m0 + mm, n = n0 + nn; if (m >= NCH) return;
        const float inner = 1.5957691216057308f * (y + 0.044715f * y * y * y);
        const float zv = y * fast_sigmoid(inner);
        Z[((size_t)m * 32 + (n >> 4)) * 512 + g * 16 + (n & 15)] = (bf16)(pk2(zv, 0.f) & 0xffffu);
    } };

__device__ __forceinline__ void s5a_phase(ArgsP a, LAS unsigned char* lds) {
    unsigned char* ws = a->ws;
    for (int unit = blockIdx.x; unit < 32 * 17; unit += gridDim.x) {
        const int g = unit / 17, mt = unit % 17;
        SEpiA E{(float*)(ws + WS_S), mt * 128, g};
        const bf16* A0 = (const bf16*)(ws + WS_U2) + (size_t)g * MR * 16 + (size_t)mt * 128 * 512;
        sgemm_unit(lds, A0, 512, 8, A0, 512, 0, 0, (const bf16*)(ws + WS_WST) + (size_t)g * 128 * 512, 512, E);
    }
    __syncthreads();
}
__device__ __forceinline__ void s5b_phase(ArgsP a, LAS unsigned char* lds) {
    unsigned char* ws = a->ws;
    for (int unit = blockIdx.x; unit < 32 * 17 * 4; unit += gridDim.x) {
        const int g = unit / 68, mt = (unit % 68) >> 2, nt = unit & 3;
        SEpiB E{(bf16*)(ws + WS_Z), mt * 128, nt * 128, g};
        const bf16* A0 = (const bf16*)(ws + WS_U2) + (size_t)g * MR * 16 + (size_t)mt * 128 * 512;
        const bf16* A1 = (const bf16*)(ws + WS_XPREV) + ((size_t)mt * 128 * 32 + g) * 128;
        sgemm_unit(lds, A0, 512, 2 * nt + 2, A1, 32 * 128, 2, 512, (const bf16*)(ws + WS_W2) + ((size_t)g * 512 + nt * 128) * 640, 640, E);
    }
    __syncthreads();
}
__device__ __forceinline__ void s5_carry(ArgsP a, int gtid, int gthreads) {
    unsigned char* ws = a->ws;
    const f32x2* pw = (const f32x2*)(ws + WS_PW); const float* S = (const float*)(ws + WS_S); bf16* XP = (bf16*)(ws + WS_XPREV);
    for (int idx = gtid; idx < 2 * 65536; idx += gthreads) {
        const int j = idx & 65535, b = j >> 11, g = (j >> 6) & 31, p = j & 63;
        const f32x2 w = pw[(g * 33 + 32) * 64 + p];
        if (idx < 65536) {
            float xr = 0.f, xi = 0.f;
#pragma unroll 8
            for (int c = 0; c < 64; ++c) {
                const size_t o = ((size_t)(b * 64 + c) * 32 + g) * 128 + p;
                XP[o] = (bf16)(pk2(xr, 0.f) & 0xffffu); XP[o + 64] = (bf16)(pk2(xi, 0.f) & 0xffffu);
                const float sr = S[o], si = S[o + 64];
                const float nr = w.x * xr - w.y * xi + sr, ni = w.x * xi + w.y * xr + si;
                xr = nr; xi = ni;
            }
            a->out[O_PRE + j] = xr; a->out[O_PIM + j] = xi;
        } else {
            const float x0r = a->in[4][j], x0i = a->in[5][j];
            const size_t o = ((size_t)(2048 + b) * 32 + g) * 128 + p;
            XP[o] = (bf16)(pk2(x0r, 0.f) & 0xffffu); XP[o + 64] = (bf16)(pk2(x0i, 0.f) & 0xffffu);
            a->out[O_SRE + j] = w.x * x0r - w.y * x0i + S[o]; a->out[O_SIM + j] = w.x * x0i + w.y * x0r + S[o + 64];
        }
    }
}

constexpr int AT_KP = 208, AT_VP = 144, AT_VOFF = 64 * AT_KP  , AT_TB = AT_VOFF + 64 * AT_VP  ;
__device__ __forceinline__ void attn_unit(LAS unsigned char* lds, const bf16* Q, const bf16* KN, const bf16* KR, const bf16* Vt, bf16* MIX, int h,
                                          size_t qrow0, bool active, int nt_w, int NT, size_t krow0, size_t krow_last, int nvalid_last) {
    const int tid = threadIdx.x, lane = tid & 63, r32 = lane & 31, hi = lane >> 5;
    bf16x8 qf[6];
    if (active) {
        const bf16* qp = Q + (qrow0 + r32) * 768;
#pragma unroll
        for (int j = 0; j < 4; ++j) qf[j] = *(const bf16x8*)(qp + h * 64 + 16 * j + 8 * hi);
#pragma unroll
        for (int j = 0; j < 2; ++j) qf[4 + j] = *(const bf16x8*)(qp + 512 + h * 32 + 16 * j + 8 * hi);
    } else {
#pragma unroll
        for (int j = 0; j < 6; ++j) qf[j] = (bf16x8){0, 0, 0, 0, 0, 0, 0, 0};
    }
    f32x16 ot0 = {}, ot1 = {};
    float m_run = -1e30f, lsum = 0.f;
    u32x4 rkn, rkr = {0, 0, 0, 0}, rvt;
    auto gload = [&](int t) {
        const size_t kb = (nvalid_last < 64 && t == NT - 1) ? krow_last : krow0 + (size_t)64 * t;
        rkn = *(const u32x4*)(KN + (kb + (tid >> 3)) * 512 + h * 64 + (tid & 7) * 8);
        if (tid < 256) rkr = *(const u32x4*)(KR + (kb + (tid >> 2)) * 32 + (tid & 3) * 8);
        rvt = *(const u32x4*)(Vt + (size_t)(h * 64 + (tid >> 3)) * MKV + kb + (tid & 7) * 8);
    };
    const int pi_r = (r32 & 0x13) | ((r32 & 4) << 1) | ((r32 & 8) >> 1);
    gload(0);
    for (int t = 0; t < NT; ++t) {
        LAS unsigned char* tb = lds + (t & 1) * AT_TB;
        *(LAS u32x4*)(tb + (tid >> 3) * AT_KP + (tid & 7) * 16) = rkn;
        if (tid < 256) *(LAS u32x4*)(tb + (tid >> 2) * AT_KP + 128 + (tid & 3) * 16) = rkr;
        *(LAS u32x4*)(tb + AT_VOFF + (tid >> 3) * AT_VP + (tid & 7) * 16) = rvt;
        __syncthreads();
        if (t + 1 < NT) gload(t + 1);
        if (active && t < nt_w) {
            f32x16 p0 = {}, p1 = {};
            const LAS unsigned char* kp = tb + pi_r * AT_KP + hi * 16;
#pragma unroll
            for (int j = 0; j < 6; ++j) {
                const bf16x8 a0 = *(const LAS bf16x8*)(kp + j * 32), a1 = *(const LAS bf16x8*)(kp + 32 * AT_KP + j * 32);
                p0 = __builtin_amdgcn_mfma_f32_32x32x16_bf16(a0, qf[j], p0, 0, 0, 0);
                p1 = __builtin_amdgcn_mfma_f32_32x32x16_bf16(a1, qf[j], p1, 0, 0, 0);
            }
            if (nvalid_last < 64 && t == NT - 1) {
#pragma unroll
                for (int r = 0; r < 16; ++r) { const int key = (r & 7) + 8 * hi + 16 * (r >> 3); if (key >= nvalid_last) p0[r] = -1e30f; if (key + 32 >= nvalid_last) p1[r] = -1e30f; }
            }
            float mx = fmaxf(p0[0], p1[0]);
#pragma unroll
            for (int r = 1; r < 16; ++r) mx = fmaxf(mx, fmaxf(p0[r], p1[r]));
            mx = fmaxf(mx, __shfl_xor(mx, 32));
            const float mnew = fmaxf(m_run, mx), alpha = __builtin_amdgcn_exp2f(m_run - mnew);
            m_run = mnew;
            float ps = 0.f;
#pragma unroll
            for (int r = 0; r < 16; ++r) { p0[r] = __builtin_amdgcn_exp2f(p0[r] - mnew); p1[r] = __builtin_amdgcn_exp2f(p1[r] - mnew); ps += p0[r] + p1[r]; }
            lsum = lsum * alpha + ps;
            ot0 = ot0 * alpha; ot1 = ot1 * alpha;
            bf16x8 pf[4];
            { u32x4 w;
              w.x = pk2(p0[0], p0[1]); w.y = pk2(p0[2], p0[3]); w.z = pk2(p0[4], p0[5]); w.w = pk2(p0[6], p0[7]); pf[0] = __builtin_bit_cast(bf16x8, w);
              w.x = pk2(p0[8], p0[9]); w.y = pk2(p0[10], p0[11]); w.z = pk2(p0[12], p0[13]); w.w = pk2(p0[14], p0[15]); pf[1] = __builtin_bit_cast(bf16x8, w);
              w.x = pk2(p1[0], p1[1]); w.y = pk2(p1[2], p1[3]); w.z = pk2(p1[4], p1[5]); w.w = pk2(p1[6], p1[7]); pf[2] = __builtin_bit_cast(bf16x8, w);
              w.x = pk2(p1[8], p1[9]); w.y = pk2(p1[10], p1[11]); w.z = pk2(p1[12], p1[13]); w.w = pk2(p1[14], p1[15]); pf[3] = __builtin_bit_cast(bf16x8, w); }
            const LAS unsigned char* vp = tb + AT_VOFF + r32 * AT_VP + hi * 16;
#pragma unroll
            for (int jj = 0; jj < 4; ++jj) {
                const bf16x8 v0 = *(const LAS bf16x8*)(vp + jj * 32), v1 = *(const LAS bf16x8*)(vp + 32 * AT_VP + jj * 32);
                ot0 = __builtin_amdgcn_mfma_f32_32x32x16_bf16(v0, pf[jj], ot0, 0, 0, 0);
                ot1 = __builtin_amdgcn_mfma_f32_32x32x16_bf16(v1, pf[jj], ot1, 0, 0, 0);
            }
        }
    }
    if (active) {
        const float l = lsum + __shfl_xor(lsum, 32), inv = 1.0f / l;
        bf16* op = MIX + (qrow0 + r32) * 1024 + h * 64 + 4 * hi;
#pragma unroll
        for (int c = 0; c < 4; ++c) {
            u32x2 w; w.x = pk2(ot0[4 * c] * inv, ot0[4 * c + 1] * inv); w.y = pk2(ot0[4 * c + 2] * inv, ot0[4 * c + 3] * inv); *(u32x2*)(op + 8 * c) = w;
            w.x = pk2(ot1[4 * c] * inv, ot1[4 * c + 1] * inv); w.y = pk2(ot1[4 * c + 2] * inv, ot1[4 * c + 3] * inv); *(u32x2*)(op + 32 + 8 * c) = w;
        }
    }
    __syncthreads();
}
__device__ __forceinline__ void attn_phase(ArgsP a, LAS unsigned char* lds) {
    unsigned char* ws = a->ws;
    const bf16* Q = (const bf16*)(ws + WS_Q); const bf16* KN = (const bf16*)(ws + WS_KN); const bf16* KR = (const bf16*)(ws + WS_KR); const bf16* Vt = (const bf16*)(ws + WS_VT); bf16* MIX = (bf16*)(ws + WS_MIX);
    const int wid = threadIdx.x >> 6;
    for (int v = blockIdx.x; v < 256; v += gridDim.x) {
        const int b = v >> 3, h = v & 7;
        for (int qb = 7; qb >= 0; --qb)
            attn_unit(lds, Q, KN, KR, Vt, MIX, h, (size_t)b * SEQ + 256 * qb + 32 * wid, true, 4 * qb + (wid >> 1) + 1, 4 * qb + 4, (size_t)b * SEQ, 0, 64);
        attn_unit(lds, Q, KN, KR, Vt, MIX, h, (size_t)NP + b * DECS, wid == 0, 33, 33, (size_t)MR + (size_t)b * PAST, (size_t)NP + b * DECS, 32);
    }
}

__device__ __forceinline__ void mixnorm_phase(ArgsP a, int gw, int ngw, int lane) {
    bf16* MIX = (bf16*)(a->ws + WS_MIX);
    for (int row = gw; row < MR; row += ngw) {
        bf16* p = MIX + (size_t)row * 1024 + 16 * lane;
        const u32x4 r0 = *(const u32x4*)p, r1 = *(const u32x4*)(p + 8);
        float v[16];
        const unsigned w[8] = {r0.x, r0.y, r0.z, r0.w, r1.x, r1.y, r1.z, r1.w};
        float s = 0.f;
#pragma unroll
        for (int i = 0; i < 8; ++i) { v[2 * i] = __uint_as_float(w[i] << 16); v[2 * i + 1] = __uint_as_float(w[i] & 0xffff0000u); s += v[2 * i] * v[2 * i] + v[2 * i + 1] * v[2 * i + 1]; }
#pragma unroll
        for (int o = 1; o < 32; o <<= 1) s += __shfl_xor(s, o);
        const float rs = rsqrtf(s * (1.0f / 512) + EPS);
        u32x4 o0, o1;
        o0.x = pk2(v[0] * rs, v[1] * rs); o0.y = pk2(v[2] * rs, v[3] * rs); o0.z = pk2(v[4] * rs, v[5] * rs); o0.w = pk2(v[6] * rs, v[7] * rs);
        o1.x = pk2(v[8] * rs, v[9] * rs); o1.y = pk2(v[10] * rs, v[11] * rs); o1.z = pk2(v[12] * rs, v[13] * rs); o1.w = pk2(v[14] * rs, v[15] * rs);
        *(u32x4*)p = o0; *(u32x4*)(p + 8) = o1;
    }
}
__device__ __forceinline__ void final_phase(ArgsP a, int gw, int ngw, int lane) {
    float* Y = a->out + O_Y; const float* gf = a->in[29];
    f32x4 g4[4];
#pragma unroll
    for (int j = 0; j < 4; ++j) g4[j] = *(const f32x4*)(gf + 4 * lane + 256 * j);
    for (int row = gw; row < MR; row += ngw) {
        float* p = Y + (size_t)row * DM + 4 * lane;
        f32x4 v[4]; float s = 0.f;
#pragma unroll
        for (int j = 0; j < 4; ++j) { v[j] = *(const f32x4*)(p + 256 * j); s += sumsq4(v[j]); }
        s = wave_sum(s);
        const float rs = rsqrtf(s * (1.0f / DM) + EPS);
#pragma unroll
        for (int j = 0; j < 4; ++j) *(f32x4*)(p + 256 * j) = v[j] * rs * g4[j];
    }
}

constexpr int LDS_BYTES = 131072 + 1024;
constexpr int NPHASE = 11;
template <class Epi>
__device__ __forceinline__ void run_gemm(LAS unsigned char* lds, const bf16* A, const bf16* Bt, int M, int N, int K, const Epi& E) {
    asm volatile("" : "+s"(K));
    pg8::Gemm g{A, Bt, M, N, K}; pg8::StaticOrder S; S.init(M, N, (int)gridDim.x, (int)blockIdx.x);
    pg8::gemm_phase<Epi, pg8::StaticOrder, true, true>(lds, g, S, E);
    __syncthreads();
}

__global__ void __launch_bounds__(NTHR, 2) mega_fwd(Args a_unused) {
    extern __shared__ __attribute__((aligned(16))) unsigned char lds_raw[];
    LAS unsigned char* lds = (LAS unsigned char*)lds_raw;
    ArgsP a = (ArgsP)__builtin_amdgcn_kernarg_segment_ptr();
#define TID_VARS const int tid = threadIdx.x, lane = tid & 63, wave = tid >> 6; const int gtid = blockIdx.x * NTHR + tid, gthreads = gridDim.x * NTHR, gw = blockIdx.x * 8 + wave, ngw = gridDim.x * 8; (void)lane; (void)gtid; (void)gthreads; (void)gw; (void)ngw;
#define ws (a->ws)
    const int lo = a->ph_lo, hi = a->ph_hi;
#ifndef PHASE_MASK
#define PHASE_MASK 0xfffff
#endif
#define IN(k) (((PHASE_MASK >> (k)) & 1) && lo <= (k) && (k) < hi)
#define SEAM(k) do { if (IN(k) && IN((k) + 1)) { __threadfence(); cg::this_grid().sync(); } } while (0)

    if (IN(0)) { TID_VARS phase0(a, gtid, gthreads, gw, ngw, lane); }
    SEAM(0);
    if (IN(1)) {
        { TID_VARS phase1_tables(a, gtid, gthreads); }
        EpiG1 E{(bf16*)(ws + WS_CKVRAW), (bf16*)(ws + WS_CQ), (bf16*)(ws + WS_U2), (float*)(ws + WS_SSQQ), (const float*)(ws + WS_RSX), (const float*)(ws + WS_ROPE), a->out, (bf16*)(ws + WS_KR)};
        run_gemm(lds, (const bf16*)(ws + WS_XB), (const bf16*)(ws + WS_WIN), MR, 1280, 1024, E);
    }
    SEAM(1);
    if (IN(2)) {
#ifndef SKIP_2A
        { TID_VARS phase2_tables(a, gtid, gthreads); phase2_ckv(a, gw, ngw, lane); }
#endif
#ifndef SKIP_2B
        EpiG2 E{(bf16*)(ws + WS_Q), (const float*)(ws + WS_SSQQ), (const float*)(ws + WS_ROPE)};
        run_gemm(lds, (const bf16*)(ws + WS_CQ), (const bf16*)(ws + WS_WUQ), MR, 768, 384, E);
#endif
#ifndef SKIP_2C
        s5a_phase(a, lds);
#endif
    }
    SEAM(2);
    if (IN(3)) {
#ifndef SKIP_3A
        { TID_VARS s5_carry(a, gtid, gthreads); }
#endif
#ifndef SKIP_3B
        { pg8::EpiBf16<0> E{(bf16*)(ws + WS_KN), 512, nullptr, 0, 0, 1.f};
          run_gemm(lds, (const bf16*)(ws + WS_CKVALL), (const bf16*)(ws + WS_WUK), MKV, 512, 256, E); }
#endif
#ifndef SKIP_3C
        { pg8::EpiBf16<0> E{(bf16*)(ws + WS_VT), MKV, nullptr, 0, 0, 1.f};
          run_gemm(lds, (const bf16*)(ws + WS_WUV), (const bf16*)(ws + WS_CKVALL), 512, MKV, 256, E); }
#endif
    }
    SEAM(3);
    if (IN(4)) { attn_phase(a, lds); s5b_phase(a, lds); }
    SEAM(4);
    if (IN(5)) {
        EpiGLU E{(const bf16*)(ws + WS_Z), a->in[21], (bf16*)(ws + WS_MIX)};
        run_gemm(lds, (const bf16*)(ws + WS_Z), (const bf16*)(ws + WS_WGLU), MR, 512, 512, E);
    }
    SEAM(5);
    if (IN(6)) { TID_VARS mixnorm_phase(a, gw, ngw, lane); }
    SEAM(6);
    if (IN(7)) {
        EpiOut E{a->in[0], a->in[1], a->out + O_Y, (bf16*)(ws + WS_X1B), (float*)(ws + WS_SSQF)};
        run_gemm(lds, (const bf16*)(ws + WS_MIX), (const bf16*)(ws + WS_WOUT), MR, 1024, 1024, E);
    }
    SEAM(7);
    if (IN(8)) {
        EpiGU E{(bf16*)(ws + WS_HID), (const float*)(ws + WS_SSQF)};
        run_gemm(lds, (const bf16*)(ws + WS_X1B), (const bf16*)(ws + WS_WGU), MR, 5632, 1024, E);
    }
    SEAM(8);
    if (IN(9)) {
        EpiDown E{a->out + O_Y};
        run_gemm(lds, (const bf16*)(ws + WS_HID), (const bf16*)(ws + WS_WDN), MR, 1024, DFF, E);
    }
    SEAM(9);
    if (IN(10)) { TID_VARS final_phase(a, gw, ngw, lane); }
#undef IN
#undef SEAM
#undef ws
}

extern "C" void kernel_launch(void* const* d_in, const int* in_sizes, int n_in, void* d_out, int out_size, void* d_ws, size_t ws_size, hipStream_t stream) {
    static int grid = 0;
    if (grid == 0) {
        if (n_in != 30 || ws_size < WS_END) { fprintf(stderr, "kernel_launch: unexpected n_in %d / ws_size %zu\n", n_in, ws_size); grid = -1; return; }
        int dev = 0, cus = 0, per_cu = 0;
        hipGetDevice(&dev); hipDeviceGetAttribute(&cus, hipDeviceAttributeMultiprocessorCount, dev);
        if (hipFuncSetAttribute((const void*)mega_fwd, hipFuncAttributeMaxDynamicSharedMemorySize, LDS_BYTES) != hipSuccess) { fprintf(stderr, "kernel_launch: hipFuncSetAttribute failed\n"); grid = -1; return; }
        if (hipOccupancyMaxActiveBlocksPerMultiprocessor(&per_cu, (const void*)mega_fwd, NTHR, LDS_BYTES) != hipSuccess || per_cu < 1) { fprintf(stderr, "kernel_launch: occupancy query says %d\n", per_cu); per_cu = 1; }
        (void)hipGetLastError();
        grid = cus * 1;
        if (grid <= 0) grid = 256;
    }
    if (grid < 0) return;
    Args a{};
    for (int i = 0; i < 30; ++i) a.in[i] = (const float*)d_in[i];
    a.out = (float*)d_out; a.ws = (unsigned char*)d_ws;
#if ONE_LAUNCH
    a.ph_lo = 0; a.ph_hi = NPHASE;
    void* args[] = {&a};
    hipError_t e = hipLaunchCooperativeKernel((const void*)mega_fwd, dim3(grid), dim3(NTHR), args, LDS_BYTES, stream);
    if (e != hipSuccess) fprintf(stderr, "cooperative launch failed: %s (grid %d)\n", hipGetErrorString(e), grid);
#else
    for (int ph = 0; ph < NPHASE; ++ph) {
        a.ph_lo = ph; a.ph_hi = ph + 1;
        hipLaunchKernelGGL(mega_fwd, dim3(grid), dim3(NTHR), LDS_BYTES, stream, a);
    }
#endif
}
```

```cpp
#include <hip/hip_runtime.h>
#include <hip/hip_cooperative_groups.h>
#include <cstdio>
#include <cstdint>
#include <hip/hip_runtime.h>
#include <cstdio>
#include <cstdint>
namespace pg8 {
#define PG8_LAS __attribute__((address_space(3)))
typedef unsigned short bf16_t;
typedef short bf16x8 __attribute__((ext_vector_type(8)));
typedef float f32x4 __attribute__((ext_vector_type(4)));
typedef unsigned u32x4 __attribute__((ext_vector_type(4)));
constexpr int BM = 256, BK = 64, HALF = 128, HTB = HALF * BK * 2  , STAGE_BYTES = 8 * HTB, NXCD = 8, WGM = 8;

__host__ __device__ __forceinline__ int lds_byte(int r, int c) { const int st = (r >> 4) * 2 + (c >> 5), rr = r & 15, cc = c & 31, ob = rr * 64 + cc * 2; return st * 1024 + (ob ^ (((ob >> 9) & 1) << 5)); }
__host__ __device__ __forceinline__ void stage_rc(int b, int& R, int& C) { const int st = b / 1024, sb = b % 1024, swz = sb ^ (((sb >> 9) & 1) << 5); R = (st >> 1) * 16 + swz / 64; C = (st & 1) * 32 + (swz % 64) / 2; }
__host__ __device__ __forceinline__ int perm32(int rho) { const int n = rho >> 4, i = rho & 15; return 8 * (i >> 2) + 4 * n + (i & 3); }

struct Unit { int pm, pn; };
struct Gemm { const bf16_t* A; const bf16_t* Bt; int M, N, K; };

struct StaticOrder {
    int nM, nN, nwg, G, c;
    __host__ __device__ void init(int M, int N, int G_, int c_) { nM = M / BM; nN = N / BM; nwg = nM * nN; G = G_; c = c_; }
    __host__ __device__ bool next(int i, Unit& u) const {
        const long L = (long)i * G + c; if (L >= nwg) return false;
        int wgid = (int)L; { const int q = nwg / NXCD, r = nwg % NXCD, xcd = wgid % NXCD, off = wgid / NXCD; wgid = (xcd < r ? xcd * (q + 1) : r * (q + 1) + (xcd - r) * q) + off; }
        const int nig = WGM * nN, gid = wgid / nig, fm = gid * WGM, gsz = (nM - fm) < WGM ? (nM - fm) : WGM;
        u.pm = fm + ((wgid % nig) % gsz); u.pn = (wgid % nig) / gsz; return true;
    }
    __device__ __forceinline__ void a_ready(const Unit&) const {}
    __device__ __forceinline__ void done(const Unit&) const {}
};

__device__ __forceinline__ unsigned cvt_pk_bf16(float lo, float hi) { unsigned r; asm volatile("v_cvt_pk_bf16_f32 %0, %1, %2" : "=v"(r) : "v"(lo), "v"(hi)); return r; }
typedef float f32x2 __attribute__((ext_vector_type(2)));
__device__ __forceinline__ f32x2 gelu_pk(f32x2 v) {
    const f32x2 av = __builtin_elementwise_abs(v), d = av * 0.2316418882f + 1.0f;
    f32x2 t; t.x = __builtin_amdgcn_rcpf(d.x); t.y = __builtin_amdgcn_rcpf(d.y);
    f32x2 q = t * 0.5307027145f + (-0.7265760135f); q = q * t + 0.7107068705f; q = q * t + (-0.142248368f); q = q * t + 0.127414796f; q = q * t;
    const f32x2 s = (v * v) * (-0.72134752044f);
    f32x2 e; e.x = __builtin_amdgcn_exp2f(s.x); e.y = __builtin_amdgcn_exp2f(s.y);
    const f32x2 m = v * (q * e), r = v - m;
    f32x2 o; o.x = v.x < 0.f ? m.x : r.x; o.y = v.y < 0.f ? m.y : r.y; return o;
}

template <int ACT  > struct EpiBf16 {
    static constexpr bool PERM = true, AFTER_DRAIN = false; static_assert(ACT == 0 || ACT == 1, "EpiBf16: ACT is 0 (none) or 1 (gelu_pk)");
    bf16_t* O; int ldc; const float* bias; int split_cols; size_t split_stride; float scale0;
    __device__ __forceinline__ void operator()(const f32x4 (&acc)[2][2][4][2], const Unit& u, int wr, int wc, int fr, int fq) const {
        const int row0 = u.pm * BM + wr * 64 + fr; int colt = u.pn * BM; bf16_t* base = O;
        float sc = 1.f; if (split_cols) { const int t = colt / split_cols; base += (size_t)t * split_stride; colt -= t * split_cols; if (t == 0) sc = scale0; }
        const int col0 = colt + wc * 32 + 8 * fq, bcol0 = u.pn * BM + wc * 32 + 8 * fq;
        f32x4 bv[2][2];
#pragma unroll
        for (int bj = 0; bj < 2; ++bj)
#pragma unroll
            for (int n = 0; n < 2; ++n) bv[bj][n] = bias ? *(const f32x4*)(bias + bcol0 + bj * HALF + 4 * n) : (f32x4){0.f, 0.f, 0.f, 0.f};
#pragma unroll
        for (int ai = 0; ai < 2; ++ai)
#pragma unroll
            for (int m = 0; m < 4; ++m) { bf16_t* rowp = base + (size_t)(row0 + ai * HALF + m * 16) * ldc + col0;
#pragma unroll
                for (int bj = 0; bj < 2; ++bj) { f32x4 v0 = acc[ai][bj][m][0] + bv[bj][0], v1 = acc[ai][bj][m][1] + bv[bj][1];
                    if (ACT == 1) { f32x2 a = gelu_pk((f32x2){v0[0], v0[1]}), b = gelu_pk((f32x2){v0[2], v0[3]}), c = gelu_pk((f32x2){v1[0], v1[1]}), d = gelu_pk((f32x2){v1[2], v1[3]});
                        v0 = (f32x4){a.x, a.y, b.x, b.y}; v1 = (f32x4){c.x, c.y, d.x, d.y}; }
                    v0 = v0 * sc; v1 = v1 * sc; u32x4 w; w.x = cvt_pk_bf16(v0[0], v0[1]); w.y = cvt_pk_bf16(v0[2], v0[3]); w.z = cvt_pk_bf16(v1[0], v1[1]); w.w = cvt_pk_bf16(v1[2], v1[3]);
                    *(u32x4*)(rowp + bj * HALF) = w; } }
    }
};
template <class Epi, class Sched, bool ALIGN_EPI = false, bool SP2 = false>
__device__ __forceinline__ void gemm_phase(PG8_LAS unsigned char* lds, const Gemm g, const Sched& S, const Epi& E) {
    const int tid = threadIdx.x, wid = __builtin_amdgcn_readfirstlane(tid >> 6), lane = tid & 63, wr = wid >> 2, wc = wid & 3, fr = lane & 15, fq = lane >> 4;
    const int K = g.K, nt = K / BK;
    unsigned voffA[2], voffB[2];
#pragma unroll
    for (int i = 0; i < 2; ++i) { int R, C; stage_rc(tid * 16 + i * 8192, R, C); const int Rb = Epi::PERM ? ((R & ~31) + perm32(R & 31)) : R;
        voffA[i] = (unsigned)(R * K + C) * 2u; voffB[i] = (unsigned)(Rb * K + C) * 2u; }
    const size_t kstep = (size_t)(BK * 2);
    const size_t hstep = (size_t)HALF * K * 2;
    const size_t tstep = 2 * hstep;
    const unsigned ldsw = (unsigned)wid * 1024u;
    const int aoff = lds_byte(wr * 64 + fr, fq * 8), boff = lds_byte(wc * 32 + fr, fq * 8);
#define PG8_SA(b, h) (((b) * 2 + (h)) * HTB)
#define PG8_SB(b, h) ((4 + (b) * 2 + (h)) * HTB)
#define PG8_STAGE(bufoff, gbase, voff) do { _Pragma("unroll") for (int _i = 0; _i < 2; ++_i) \
        __builtin_amdgcn_global_load_lds((const unsigned*)((const char*)(gbase) + (voff)[_i]), (PG8_LAS unsigned*)(lds + (bufoff) + ldsw + _i * 8192), 16, 0, 0); } while (0)
#define PG8_LDA(dst, b, h) do { _Pragma("unroll") for (int m = 0; m < 4; ++m) _Pragma("unroll") for (int k = 0; k < 2; ++k) dst[m][k] = *(const PG8_LAS bf16x8*)(lds + PG8_SA(b, h) + aoff + m * 2048 + k * 1024); } while (0)
#define PG8_LDB(dst, b, h) do { _Pragma("unroll") for (int n = 0; n < 2; ++n) _Pragma("unroll") for (int k = 0; k < 2; ++k) dst[n][k] = *(const PG8_LAS bf16x8*)(lds + PG8_SB(b, h) + boff + n * 2048 + k * 1024); } while (0)
#define PG8_MMA(ai, bj, At, Bt) do { __builtin_amdgcn_s_setprio(1); _Pragma("unroll") for (int m = 0; m < 4; ++m) _Pragma("unroll") for (int n = 0; n < 2; ++n) _Pragma("unroll") for (int k = 0; k < 2; ++k) \
        acc[ai][bj][m][n] = __builtin_amdgcn_mfma_f32_16x16x32_bf16(Bt[n][k], At[m][k], acc[ai][bj][m][n], 0, 0, 0); __builtin_amdgcn_s_setprio(0); } while (0)
#define PG8_WAIT_V(n) asm volatile("s_waitcnt vmcnt(" #n ")" ::: "memory")
#define PG8_WAIT_L(n) asm volatile("s_waitcnt lgkmcnt(" #n ")" ::: "memory")
#define PG8_BAR __builtin_amdgcn_s_barrier()
#define PG8_SCHED __builtin_amdgcn_sched_barrier(0)
    Unit cur, nxt; int ui = 0;
    if (!S.next(0, cur)) return;
    f32x4 acc[2][2][4][2];
#pragma unroll
    for (int a = 0; a < 2; ++a)
#pragma unroll
        for (int b = 0; b < 2; ++b)
#pragma unroll
            for (int m = 0; m < 4; ++m)
#pragma unroll
                for (int n = 0; n < 2; ++n) acc[a][b][m][n] = (f32x4){0.f, 0.f, 0.f, 0.f};
    bf16x8 At[4][2], B0[2][2], B1[2][2];
    const char* cA = (const char*)g.A + (size_t)cur.pm * tstep; const char* cB = (const char*)g.Bt + (size_t)cur.pn * tstep;
    S.a_ready(cur);
    if constexpr (SP2) {
        PG8_STAGE(PG8_SB(0, 0), cB, voffB); PG8_STAGE(PG8_SB(0, 1), cB + hstep, voffB); PG8_STAGE(PG8_SA(0, 0), cA, voffA); PG8_STAGE(PG8_SA(0, 1), cA + hstep, voffA);
        if (wr == 1) PG8_BAR;
        PG8_WAIT_V(2); PG8_BAR;
        PG8_STAGE(PG8_SB(1, 0), cB + kstep, voffB); PG8_STAGE(PG8_SA(1, 0), cA + kstep, voffA); PG8_STAGE(PG8_SB(1, 1), cB + hstep + kstep, voffB);
        PG8_WAIT_V(6); PG8_BAR;
    } else {
        PG8_STAGE(PG8_SB(0, 0), cB, voffB); PG8_STAGE(PG8_SA(0, 0), cA, voffA); PG8_STAGE(PG8_SB(0, 1), cB + hstep, voffB); PG8_STAGE(PG8_SA(0, 1), cA + hstep, voffA);
        if (wr == 1) PG8_BAR;
        PG8_WAIT_V(4); PG8_BAR;
        PG8_STAGE(PG8_SB(1, 0), cB + kstep, voffB); PG8_STAGE(PG8_SA(1, 0), cA + kstep, voffA); PG8_STAGE(PG8_SB(1, 1), cB + hstep + kstep, voffB);
        PG8_WAIT_V(6); PG8_BAR;
    }
    for (;;) {
        const bool has_next = S.next(ui + 1, nxt);
        const char* nA = has_next ? (const char*)g.A + (size_t)nxt.pm * tstep : cA; const char* nB = has_next ? (const char*)g.Bt + (size_t)nxt.pn * tstep : cB;
        for (int t = 0; t < nt; t += 2) {
            const bool last = (t == nt - 2);
            const char* a1 = cA + (size_t)(t + 1) * kstep;
            const char* a2 = last ? nA : cA + (size_t)(t + 2) * kstep; const char* b2 = last ? nB : cB + (size_t)(t + 2) * kstep;
            const char* a3 = a2 + kstep; const char* b3 = b2 + kstep;
            if (last && has_next) S.a_ready(nxt);
            if constexpr (SP2) {
            PG8_LDB(B0, 0, 0); PG8_LDB(B1, 0, 1); PG8_SCHED; PG8_LDA(At, 0, 0); PG8_STAGE(PG8_SA(1, 1), a1 + hstep, voffA);
            PG8_WAIT_V(8); PG8_WAIT_L(0); PG8_BAR; PG8_MMA(0, 0, At, B0); PG8_MMA(0, 1, At, B1); PG8_BAR; PG8_SCHED;
            PG8_LDA(At, 0, 1); PG8_STAGE(PG8_SB(0, 0), b2, voffB); PG8_STAGE(PG8_SB(0, 1), b2 + hstep, voffB); PG8_STAGE(PG8_SA(0, 0), a2, voffA);
            PG8_WAIT_V(8); PG8_WAIT_L(0); PG8_BAR; PG8_MMA(1, 0, At, B0); PG8_MMA(1, 1, At, B1); PG8_BAR; PG8_SCHED;
            PG8_LDB(B0, 1, 0); PG8_LDB(B1, 1, 1); PG8_SCHED; PG8_LDA(At, 1, 0); PG8_STAGE(PG8_SA(0, 1), a2 + hstep, voffA);
            PG8_WAIT_V(8); PG8_WAIT_L(0); PG8_BAR; PG8_MMA(0, 0, At, B0); PG8_MMA(0, 1, At, B1); PG8_BAR; PG8_SCHED;
            PG8_LDA(At, 1, 1); PG8_STAGE(PG8_SB(1, 0), b3, voffB); PG8_STAGE(PG8_SB(1, 1), b3 + hstep, voffB); PG8_STAGE(PG8_SA(1, 0), a3, voffA);
            PG8_WAIT_V(8); PG8_WAIT_L(0); PG8_BAR; PG8_MMA(1, 0, At, B0); PG8_MMA(1, 1, At, B1); PG8_BAR; PG8_SCHED;
            } else {
            PG8_LDB(B0, 0, 0); PG8_SCHED; PG8_LDA(At, 0, 0); PG8_STAGE(PG8_SA(1, 1), a1 + hstep, voffA);
            PG8_WAIT_L(8); PG8_BAR; PG8_WAIT_L(0); PG8_MMA(0, 0, At, B0); PG8_BAR; PG8_SCHED;
            PG8_LDB(B1, 0, 1); PG8_STAGE(PG8_SB(0, 0), b2, voffB);
            PG8_BAR; PG8_WAIT_L(0); PG8_MMA(0, 1, At, B1); PG8_BAR;
            PG8_LDA(At, 0, 1); PG8_STAGE(PG8_SA(0, 0), a2, voffA);
            PG8_BAR; PG8_WAIT_L(0); PG8_MMA(1, 0, At, B0); PG8_BAR; PG8_SCHED;
            PG8_STAGE(PG8_SB(0, 1), b2 + hstep, voffB);
            PG8_WAIT_V(6); PG8_BAR; PG8_MMA(1, 1, At, B1); PG8_BAR;
            PG8_LDB(B0, 1, 0); PG8_SCHED; PG8_LDA(At, 1, 0); PG8_STAGE(PG8_SA(0, 1), a2 + hstep, voffA);
            PG8_WAIT_L(8); PG8_BAR; PG8_WAIT_L(0); PG8_MMA(0, 0, At, B0); PG8_BAR; PG8_SCHED;
            PG8_LDB(B1, 1, 1); PG8_STAGE(PG8_SB(1, 0), b3, voffB);
            PG8_BAR; PG8_WAIT_L(0); PG8_MMA(0, 1, At, B1); PG8_BAR;
            PG8_LDA(At, 1, 1); PG8_STAGE(PG8_SA(1, 0), a3, voffA);
            PG8_BAR; PG8_WAIT_L(0); PG8_MMA(1, 0, At, B0); PG8_BAR; PG8_SCHED;
            PG8_STAGE(PG8_SB(1, 1), b3 + hstep, voffB);
            PG8_WAIT_V(6); PG8_BAR; PG8_MMA(1, 1, At, B1); PG8_BAR;
            }
        }
        if constexpr (ALIGN_EPI) { if (wr == 0) PG8_BAR; }
        if constexpr (!Epi::AFTER_DRAIN) { E(acc, cur, wr, wc, fr, fq); S.done(cur); }
        if (!has_next) break;
#pragma unroll
        for (int a = 0; a < 2; ++a)
#pragma unroll
            for (int b = 0; b < 2; ++b)
#pragma unroll
                for (int m = 0; m < 4; ++m)
#pragma unroll
                    for (int n = 0; n < 2; ++n) acc[a][b][m][n] = (f32x4){0.f, 0.f, 0.f, 0.f};
        cur = nxt; cA = nA; cB = nB; ++ui;
        if constexpr (ALIGN_EPI) { if (wr == 1) PG8_BAR; }
    }
    PG8_WAIT_V(0);
    if constexpr (!ALIGN_EPI) { if (wr == 0) PG8_BAR; }
    PG8_BAR;
    if constexpr (Epi::AFTER_DRAIN) { E.fused(acc, cur, wr, wc, fr, fq, lds, wid, lane); S.done(cur); }
#undef PG8_SA
#undef PG8_SB
#undef PG8_STAGE
#undef PG8_LDA
#undef PG8_LDB
#undef PG8_MMA
#undef PG8_WAIT_V
#undef PG8_WAIT_L
#undef PG8_BAR
#undef PG8_SCHED
}
}
#define LAS __attribute__((address_space(3)))
#define XB_TMO      128
#define XB_XCNT(j)  (256  + 64 * (j))
#define XB_XSUB(j)  (1280 + 64 * (j))
#define XB_XGEN(j)  (2304 + 64 * (j))
#define XB_TOP      3328
#define XB_TOPGEN   3392
#define XCD_BAR_WORDS 3456
#define XB_SPIN_CAP (1u << 18)

__device__ __forceinline__ unsigned xb_ld(unsigned* p)              { return __hip_atomic_load(p, __ATOMIC_RELAXED, __HIP_MEMORY_SCOPE_AGENT); }
__device__ __forceinline__ unsigned xb_add(unsigned* p, unsigned v) { return __hip_atomic_fetch_add(p, v, __ATOMIC_RELAXED, __HIP_MEMORY_SCOPE_AGENT); }
__device__ __forceinline__ unsigned xb_xcc_id() { return (unsigned)__builtin_amdgcn_s_getreg((3 << 11) | 20) & 0xFu; }
#define XB_SPIN(cond, bar) do { unsigned _sp = 0; while (cond) { __builtin_amdgcn_s_sleep(1); \
    if ((++_sp & 255u) == 0u) { if (xb_ld(&(bar)[XB_TMO])) break; if (_sp > XB_SPIN_CAP) { atomicAdd(&(bar)[XB_TMO], 1u); break; } } } } while (0)

struct XcdBarrier {
    unsigned* bar; unsigned x;
    volatile LAS unsigned* st;
};

__device__ __forceinline__ XcdBarrier xcd_barrier_post(unsigned* bar, volatile LAS unsigned* st) {
    XcdBarrier b; b.bar = bar; b.x = xb_xcc_id(); b.st = st;
    if (threadIdx.x == 0) (void)xb_add(&bar[XB_XCNT(b.x)], 1u);
    return b;
}
__device__ __forceinline__ void xcd_barrier_complete(unsigned* bar, unsigned x, unsigned& nloc, unsigned& nx) {
    const unsigned G = gridDim.x * gridDim.y * gridDim.z;
    unsigned sum, cnt, mine, sp = 0u;
    for (;;) {
        sum = 0u; cnt = 0u; mine = 0u;
#pragma unroll
        for (unsigned j = 0; j < 16; ++j) { const unsigned c = xb_ld(&bar[XB_XCNT(j)]); sum += c; cnt += (c > 0u) ? 1u : 0u; mine = (j == x) ? c : mine; }
        if (sum == G) break;
        __builtin_amdgcn_s_sleep(1);
        if ((++sp & 255u) == 0u) { if (xb_ld(&bar[XB_TMO])) break; if (sp > XB_SPIN_CAP) { atomicAdd(&bar[XB_TMO], 1u); break; } }
    }
    nloc = mine > 0u ? mine : 1u; nx = cnt > 0u ? cnt : 1u;
}

__device__ __forceinline__ void xcd_barrier(const XcdBarrier& b) {
    asm volatile("s_waitcnt vmcnt(0)" ::: "memory");
    __syncthreads();
    if (threadIdx.x == 0) {
        unsigned* bar = b.bar;
        __builtin_amdgcn_s_waitcnt(0);
        unsigned nloc = b.st[0], nx = b.st[1];
        if (nloc == 0u) { xcd_barrier_complete(bar, b.x, nloc, nx); b.st[0] = nloc; b.st[1] = nx; }
        const unsigned old = xb_add(&bar[XB_XSUB(b.x)], 1u);
        const unsigned gen = old / nloc;
        if (old + 1u == (gen + 1u) * nloc) {
            __builtin_amdgcn_fence(__ATOMIC_RELEASE, "agent");
            asm volatile("s_waitcnt vmcnt(0)" ::: "memory");
            const unsigned og = xb_add(&bar[XB_TOP], 1u);
            const unsigned tg = og / nx;
            if (og + 1u == (tg + 1u) * nx) xb_add(&bar[XB_TOPGEN], 1u);
            else XB_SPIN(xb_ld(&bar[XB_TOPGEN]) == tg, bar);
            __builtin_amdgcn_fence(__ATOMIC_ACQUIRE, "agent");
            xb_add(&bar[XB_XGEN(b.x)], 1u);
            asm volatile("s_waitcnt vmcnt(0)" ::: "memory");
        } else {
            XB_SPIN(xb_ld(&bar[XB_XGEN(b.x)]) == gen, bar);
            __builtin_amdgcn_fence(__ATOMIC_ACQUIRE, "agent");
            asm volatile("s_waitcnt vmcnt(0)" ::: "memory");
        }
    }
    __syncthreads();
}

namespace cg = cooperative_groups;
#define LAS __attribute__((address_space(3)))
typedef unsigned short bf16;
typedef float f32x4 __attribute__((ext_vector_type(4)));
typedef float f32x2 __attribute__((ext_vector_type(2)));
typedef float f32x16 __attribute__((ext_vector_type(16)));
typedef unsigned u32x4 __attribute__((ext_vector_type(4)));
typedef unsigned u32x2 __attribute__((ext_vector_type(2)));
typedef short bf16x8 __attribute__((ext_vector_type(8)));

#ifndef ONE_LAUNCH
#define ONE_LAUNCH 1
#endif

constexpr int NTHR = 512;
constexpr int DM = 1024, NP = 65536, NSAMP = 1024, MR = NP + NSAMP  , MKV = NP + NSAMP + 65536  ;
constexpr int SEQ = 2048, DECS = 32, PAST = 2048;
constexpr int QLORA = 384, KVL = 256, ROPE = 32, S5W = 512, INW = 1184, DFF = 2816;
constexpr int NCH = 2080;
constexpr int NCHP = 2176;
constexpr float EPS = 1e-6f;
constexpr float QSCALE = 0.10206207261596577f * 1.4426950408889634f;

constexpr size_t O_Y = 0, O_PCKV = 68157440, O_PKR = 84934656, O_PRE = 87031808, O_PIM = 87097344, O_SCKV = 87162880, O_SKR = 87425024, O_SRE = 87457792, O_SIM = 87523328;

constexpr size_t MiB = 1u << 20;
constexpr size_t WS_SSQQ = 0, WS_SSQF = MiB / 2, WS_RSX = MiB, WS_ROPE = MiB * 3 / 2, WS_PW = 2 * MiB, WS_BBAR = 3 * MiB, WS_KG = MiB * 7 / 2;
constexpr size_t WS_WIN = 5 * MiB, WS_WUQ = 8 * MiB, WS_WUK = MiB * 35 / 4, WS_WUV = 9 * MiB, WS_WGLU = MiB * 19 / 2, WS_WOUT = 10 * MiB, WS_WGU = 12 * MiB, WS_WDN = 23 * MiB;
constexpr size_t WS_WST = 29 * MiB, WS_W2 = 33 * MiB;
constexpr size_t WS_MIX = 64 * MiB, WS_XB = 194 * MiB, WS_U2 = 324 * MiB, WS_CKVRAW = 390 * MiB, WS_CQ = 423 * MiB, WS_Q = 472 * MiB, WS_CKVALL = 570 * MiB, WS_KR = 635 * MiB;
constexpr size_t WS_KN = 644 * MiB, WS_VT = 773 * MiB, WS_Z = 902 * MiB, WS_S = 967 * MiB, WS_XPREV = 1001 * MiB, WS_END = 1018 * MiB;
constexpr size_t WS_HID = 324 * MiB, WS_X1B = WS_XB;
constexpr size_t WS_CTL = 56 * MiB, CTL_BYTES = 16384;

struct Args {
    const float* in[30];
    float* out; unsigned char* ws;
    int ph_lo, ph_hi;
};
typedef const __attribute__((address_space(4))) Args* ArgsP;

__device__ __forceinline__ float bf2f(unsigned short b) { return __uint_as_float((unsigned)b << 16); }
__device__ __forceinline__ unsigned pk2(float lo, float hi) { return pg8::cvt_pk_bf16(lo, hi); }
__device__ __forceinline__ u32x4 pack8(f32x4 a, f32x4 b) { u32x4 w; w.x = pk2(a[0], a[1]); w.y = pk2(a[2], a[3]); w.z = pk2(b[0], b[1]); w.w = pk2(b[2], b[3]); return w; }
__device__ __forceinline__ u32x2 pack4(f32x4 a) { u32x2 w; w.x = pk2(a[0], a[1]); w.y = pk2(a[2], a[3]); return w; }
__device__ __forceinline__ float sumsq4(f32x4 a) { return (a[0] * a[0] + a[1] * a[1]) + (a[2] * a[2] + a[3] * a[3]); }
__device__ __forceinline__ float wave_sum(float v) {
#pragma unroll
    for (int o = 1; o < 64; o <<= 1) v += __shfl_xor(v, o);
    return v;
}
__device__ __forceinline__ float fast_sigmoid(float v) { return __builtin_amdgcn_rcpf(1.0f + __expf(-v)); }

using pg8::Unit;
#define EPI_HDR static constexpr bool PERM = true, AFTER_DRAIN = false;
#define EPI_ARGS const f32x4 (&acc)[2][2][4][2], const Unit& u, int wr, int wc, int fr, int fq

struct EpiG1 {
    EPI_HDR
    bf16* CKVraw; bf16* CQ; bf16* U2; float* ssq_q; const float* rs_x; const float* rope; float* out; bf16* KR;
    __device__ __forceinline__ void operator()(EPI_ARGS) const {
        const int pn = u.pn;
#pragma unroll
        for (int ai = 0; ai < 2; ++ai)
#pragma unroll
            for (int m = 0; m < 4; ++m) {
                const int row = u.pm * 256 + ai * 128 + wr * 64 + m * 16 + fr;
                const float rs = rs_x[row];
                float ss = 0.f;
#pragma unroll
                for (int bj = 0; bj < 2; ++bj) {
                    const f32x4 v0 = acc[ai][bj][m][0] * rs, v1 = acc[ai][bj][m][1] * rs;
                    const int cl = bj * 128 + wc * 32 + 8 * fq;
                    if (pn == 0) { *(u32x4*)(CKVraw + (size_t)row * 256 + cl) = pack8(v0, v1); }
                    else if (pn == 1) { *(u32x4*)(CQ + (size_t)row * 384 + cl) = pack8(v0, v1); ss += sumsq4(v0) + sumsq4(v1); }
                    else if (pn == 2) {
                        if (bj == 0) { *(u32x4*)(CQ + (size_t)row * 384 + 256 + cl) = pack8(v0, v1); ss += sumsq4(v0) + sumsq4(v1); }
                        else if (wc == 0) {
                            const int pos = row < NP ? (row & (SEQ - 1)) : PAST + ((row - NP) & (DECS - 1));
                            const f32x4 c4 = *(const f32x4*)(rope + pos * 32 + 4 * fq), s4 = *(const f32x4*)(rope + pos * 32 + 16 + 4 * fq);
                            const f32x4 o1 = v0 * c4 - v1 * s4, o2 = v1 * c4 + v0 * s4;
                            float* dst = row < NP ? out + O_PKR + (size_t)row * 32 : out + O_SKR + (size_t)(row - NP) * 32;
                            *(f32x4*)(dst + 4 * fq) = o1; *(f32x4*)(dst + 16 + 4 * fq) = o2;
                            *(u32x2*)(KR + (size_t)row * 32 + 4 * fq) = pack4(o1); *(u32x2*)(KR + (size_t)row * 32 + 16 + 4 * fq) = pack4(o2);
                        }
                    } else {
                        const int c = (pn - 3) * 256 + cl, g = c >> 4;
                        *(u32x4*)(U2 + ((size_t)g * MR + row) * 16 + (c & 15)) = pack8(v0, v1);
                    }
                }
                if (pn == 1 || pn == 2) { ss += __shfl_xor(ss, 16); ss += __shfl_xor(ss, 32); if (fq == 0) atomicAdd(ssq_q + row, ss); }
                asm volatile("" ::: "memory");
            }
    }
};

struct EpiG2 {
    EPI_HDR
    bf16* Q; const float* ssq_q; const float* rope;
    __device__ __forceinline__ void operator()(EPI_ARGS) const {
        const int pn = u.pn;
#pragma unroll
        for (int ai = 0; ai < 2; ++ai)
#pragma unroll
            for (int m = 0; m < 4; ++m) {
                const int row = u.pm * 256 + ai * 128 + wr * 64 + m * 16 + fr;
                const float rs = rsqrtf(ssq_q[row] * (1.0f / QLORA) + EPS);
                const int pos = row < NP ? (row & (SEQ - 1)) : PAST + ((row - NP) & (DECS - 1));
#pragma unroll
                for (int bj = 0; bj < 2; ++bj) {
                    const f32x4 v0 = acc[ai][bj][m][0] * rs, v1 = acc[ai][bj][m][1] * rs;
                    if (pn < 2) { *(u32x4*)(Q + (size_t)row * 768 + pn * 256 + bj * 128 + wc * 32 + 8 * fq) = pack8(v0, v1); }
                    else {
                        const int head = bj * 4 + wc;
                        const f32x4 c4 = *(const f32x4*)(rope + pos * 32 + 4 * fq), s4 = *(const f32x4*)(rope + pos * 32 + 16 + 4 * fq);
                        const f32x4 o1 = v0 * c4 - v1 * s4, o2 = v1 * c4 + v0 * s4;
                        *(u32x2*)(Q + (size_t)row * 768 + 512 + head * 32 + 4 * fq) = pack4(o1);
                        *(u32x2*)(Q + (size_t)row * 768 + 512 + head * 32 + 16 + 4 * fq) = pack4(o2);
                    }
                }
                asm volatile("" ::: "memory");
            }
    }
};

struct EpiGLU {
    EPI_HDR
    const bf16* Z; const float* bias; bf16* MIX;
    __device__ __forceinline__ void operator()(EPI_ARGS) const {
#pragma unroll
        for (int bj = 0; bj < 2; ++bj) {
            const int col = u.pn * 256 + bj * 128 + wc * 32 + 8 * fq;
            const f32x4 b0 = *(const f32x4*)(bias + col), b1 = *(const f32x4*)(bias + col + 4);
#pragma unroll
            for (int ai = 0; ai < 2; ++ai)
#pragma unroll
                for (int m = 0; m < 4; ++m) {
                    const int row = u.pm * 256 + ai * 128 + wr * 64 + m * 16 + fr;
                    const u32x4 zz = *(const u32x4*)(Z + (size_t)row * 512 + col);
                    f32x4 z0, z1;
                    z0[0] = __uint_as_float(zz.x << 16); z0[1] = __uint_as_float(zz.x & 0xffff0000u); z0[2] = __uint_as_float(zz.y << 16); z0[3] = __uint_as_float(zz.y & 0xffff0000u);
                    z1[0] = __uint_as_float(zz.z << 16); z1[1] = __uint_as_float(zz.z & 0xffff0000u); z1[2] = __uint_as_float(zz.w << 16); z1[3] = __uint_as_float(zz.w & 0xffff0000u);
                    const f32x4 a0 = acc[ai][bj][m][0] + b0, a1 = acc[ai][bj][m][1] + b1;
                    f32x4 o0, o1;
#pragma unroll
                    for (int i = 0; i < 4; ++i) { o0[i] = z0[i] * fast_sigmoid(a0[i]); o1[i] = z1[i] * fast_sigmoid(a1[i]); }
                    *(u32x4*)(MIX + (size_t)row * 1024 + 512 + col) = pack8(o0, o1);
                    asm volatile("" ::: "memory");
                }
        }
    }
};

struct EpiOut {
    EPI_HDR
    const float* xp; const float* xs; float* Y; bf16* X1B; float* ssq_f;
    __device__ __forceinline__ void operator()(EPI_ARGS) const {
#pragma unroll
        for (int ai = 0; ai < 2; ++ai)
#pragma unroll
            for (int m = 0; m < 4; ++m) {
                const int row = u.pm * 256 + ai * 128 + wr * 64 + m * 16 + fr;
                const float* xsrc = row < NP ? xp + (size_t)row * DM : xs + (size_t)(row - NP) * DM;
                float ss = 0.f;
#pragma unroll
                for (int bj = 0; bj < 2; ++bj) {
                    const int col = u.pn * 256 + bj * 128 + wc * 32 + 8 * fq;
                    const f32x4 y0 = *(const f32x4*)(xsrc + col) + acc[ai][bj][m][0], y1 = *(const f32x4*)(xsrc + col + 4) + acc[ai][bj][m][1];
                    *(f32x4*)(Y + (size_t)row * DM + col) = y0; *(f32x4*)(Y + (size_t)row * DM + col + 4) = y1;
                    *(u32x4*)(X1B + (size_t)row * DM + col) = pack8(y0, y1);
                    ss += sumsq4(y0) + sumsq4(y1);
                }
                ss += __shfl_xor(ss, 16); ss += __shfl_xor(ss, 32);
                if (fq == 0) atomicAdd(ssq_f + row, ss);
                asm volatile("" ::: "memory");
            }
    }
};

struct EpiGU {
    EPI_HDR
    bf16* HID; const float* ssq_f;
    __device__ __forceinline__ void operator()(EPI_ARGS) const {
#pragma unroll
        for (int ai = 0; ai < 2; ++ai)
#pragma unroll
            for (int m = 0; m < 4; ++m) {
                const int row = u.pm * 256 + ai * 128 + wr * 64 + m * 16 + fr;
                const float rs = rsqrtf(ssq_f[row] * (1.0f / DM) + EPS);
                f32x4 o[2];
#pragma unroll
                for (int n = 0; n < 2; ++n) {
                    const f32x4 g = acc[ai][0][m][n] * rs, uu = acc[ai][1][m][n] * rs;
#pragma unroll
                    for (int i = 0; i < 4; ++i) o[n][i] = g[i] * fast_sigmoid(g[i]) * uu[i];
                }
                *(u32x4*)(HID + (size_t)row * DFF + u.pn * 128 + wc * 32 + 8 * fq) = pack8(o[0], o[1]);
                asm volatile("" ::: "memory");
            }
    }
};

struct EpiDown {
    EPI_HDR
    float* Y;
    __device__ __forceinline__ void operator()(EPI_ARGS) const {
#pragma unroll
        for (int ai = 0; ai < 2; ++ai)
#pragma unroll
            for (int m = 0; m < 4; ++m) {
                const int row = u.pm * 256 + ai * 128 + wr * 64 + m * 16 + fr;
#pragma unroll
                for (int bj = 0; bj < 2; ++bj) {
                    float* p = Y + (size_t)row * DM + u.pn * 256 + bj * 128 + wc * 32 + 8 * fq;
                    const f32x4 y0 = *(const f32x4*)p + acc[ai][bj][m][0], y1 = *(const f32x4*)(p + 4) + acc[ai][bj][m][1];
                    *(f32x4*)p = y0; *(f32x4*)(p + 4) = y1;
                }
                asm volatile("" ::: "memory");
            }
    }
};

enum WKind { WK_IN = 0, WK_UQ, WK_UK, WK_UV, WK_PLAIN, WK_GU };
__device__ __forceinline__ int wsrc_col(int kind, int n) {
    switch (kind) {
    case WK_IN:
        if (n < 256) return 384 + n;
        if (n < 640) return n - 256;
        if (n < 672) { const int j = n - 640, fq = j >> 3, nn = (j >> 2) & 1, i = j & 3; return 640 + 16 * nn + 4 * fq + i; }
        if (n < 768) return -1;
        return 672 + (n - 768);
    case WK_UQ:
        if (n < 512) return (n >> 6) * 96 + (n & 63);
        { const int j = n - 512, h = j >> 5, jj = j & 31, fq = jj >> 3, nn = (jj >> 2) & 1, i = jj & 3; return h * 96 + 64 + 16 * nn + 4 * fq + i; }
    case WK_UK: return (n >> 6) * 128 + (n & 63);
    case WK_UV: return (n >> 6) * 128 + 64 + (n & 63);
    default: return n;
    }
}
__device__ __forceinline__ void conv_weight(bf16* dst, int N, int K, const float* W, const float* W2nd, int Nsrc, int kind, const float* sc0, const float* sc1, int sc_split, float mul, int gtid, int gthreads) {
    const int total = N * (K / 8);
    for (int idx = gtid; idx < total; idx += gthreads) {
        const int n = idx % N, k0 = (idx / N) * 8;
        const float* src = W; int sc;
        if (kind == WK_GU) { const int t = n >> 8, r = n & 255; sc = t * 128 + (r & 127); if (r >= 128) src = W2nd; }
        else sc = wsrc_col(kind, n);
        float v[8];
#pragma unroll
        for (int i = 0; i < 8; ++i) {
            const int k = k0 + i;
            float s = mul;
            if (sc0) s *= (k < sc_split) ? sc0[k] : sc1[k - sc_split];
            v[i] = sc >= 0 ? src[(size_t)k * Nsrc + sc] * s : 0.f;
        }
        u32x4 w; w.x = pk2(v[0], v[1]); w.y = pk2(v[2], v[3]); w.z = pk2(v[4], v[5]); w.w = pk2(v[6], v[7]);
        *(u32x4*)(dst + (size_t)n * K + k0) = w;
    }
}

__device__ __forceinline__ void phase0(ArgsP a, int gtid, int gthreads, int gw, int ngw, int lane) {
    unsigned char* ws = a->ws;
    { float* zq = (float*)(ws + WS_SSQQ); float* zf = (float*)(ws + WS_SSQF); for (int i = gtid; i < MR; i += gthreads) { zq[i] = 0.f; zf[i] = 0.f; } }
    { bf16* XB = (bf16*)(ws + WS_XB); float* rsx = (float*)(ws + WS_RSX);
      for (int row = gw; row < MR; row += ngw) {
          const float* src = row < NP ? a->in[0] + (size_t)row * DM : a->in[1] + (size_t)(row - NP) * DM;
          f32x4 v[4]; float s = 0.f;
#pragma unroll
          for (int j = 0; j < 4; ++j) { v[j] = *(const f32x4*)(src + 4 * lane + 256 * j); s += sumsq4(v[j]); }
          s = wave_sum(s);
          if (lane == 0) rsx[row] = rsqrtf(s * (1.0f / DM) + EPS);
#pragma unroll
          for (int j = 0; j < 4; ++j) *(u32x2*)(XB + (size_t)row * DM + 4 * lane + 256 * j) = pack4(v[j]);
      } }
    conv_weight((bf16*)(ws + WS_WIN), 1280, 1024, a->in[7], nullptr, INW, WK_IN, a->in[6], a->in[6], 1 << 30, 1.f, gtid, gthreads);
    conv_weight((bf16*)(ws + WS_WUQ), 768, 384, a->in[9], nullptr, 768, WK_UQ, a->in[8], a->in[8], 1 << 30, QSCALE, gtid, gthreads);
    conv_weight((bf16*)(ws + WS_WUK), 512, 256, a->in[11], nullptr, 1024, WK_UK, nullptr, nullptr, 0, 1.f, gtid, gthreads);
    conv_weight((bf16*)(ws + WS_WUV), 512, 256, a->in[11], nullptr, 1024, WK_UV, nullptr, nullptr, 0, 1.f, gtid, gthreads);
    conv_weight((bf16*)(ws + WS_WGLU), 512, 512, a->in[20], nullptr, 512, WK_PLAIN, nullptr, nullptr, 0, 1.f, gtid, gthreads);
    conv_weight((bf16*)(ws + WS_WOUT), 1024, 1024, a->in[24], nullptr, 1024, WK_PLAIN, a->in[22], a->in[23], 512, 1.f, gtid, gthreads);
    conv_weight((bf16*)(ws + WS_WGU), 5632, 1024, a->in[26], a->in[27], DFF, WK_GU, a->in[25], a->in[25], 1 << 30, 1.f, gtid, gthreads);
    conv_weight((bf16*)(ws + WS_WDN), 1024, DFF, a->in[28], nullptr, 1024, WK_PLAIN, nullptr, nullptr, 0, 1.f, gtid, gthreads);
    { float* rt = (float*)(ws + WS_ROPE);
      for (int idx = gtid; idx < (PAST + DECS) * 16; idx += gthreads) {
          const int pos = idx >> 4, i = idx & 15;
          const float inv = 1.0f / powf(10000.0f, (float)(2 * i) / 32.0f);
          const float ang = (float)pos * inv;
          rt[pos * 32 + i] = (float)cos((double)ang); rt[pos * 32 + 16 + i] = (float)sin((double)ang);
      } }
    { bf16* CK = (bf16*)(ws + WS_CKVALL) + (size_t)MR * 256; const float* src = a->in[2];
      for (int idx = gtid; idx < 65536 * 256 / 8; idx += gthreads) { const f32x4 v0 = *(const f32x4*)(src + (size_t)idx * 8), v1 = *(const f32x4*)(src + (size_t)idx * 8 + 4); *(u32x4*)(CK + (size_t)idx * 8) = pack8(v0, v1); }
      bf16* KRp = (bf16*)(ws + WS_KR) + (size_t)MR * 32; const float* s2 = a->in[3];
      for (int idx = gtid; idx < 65536 * 32 / 8; idx += gthreads) { const f32x4 v0 = *(const f32x4*)(s2 + (size_t)idx * 8), v1 = *(const f32x4*)(s2 + (size_t)idx * 8 + 4); *(u32x4*)(KRp + (size_t)idx * 8) = pack8(v0, v1); } }
    { f32x2* pw = (f32x2*)(ws + WS_PW); f32x2* bb = (f32x2*)(ws + WS_BBAR);
      for (int idx = gtid; idx < 32 * 64; idx += gthreads) {
          const int g = idx >> 6, p = idx & 63;
          const double dt = exp((double)a->in[14][g]), lr = (double)a->in[12][idx], li = (double)a->in[13][idx];
          for (int k = 0; k <= 32; ++k) { const double mag = exp(lr * dt * k), ang = li * dt * k; pw[(g * 33 + k) * 64 + p] = (f32x2){(float)(mag * cos(ang)), (float)(mag * sin(ang))}; }
          const double mag = exp(lr * dt), ang = li * dt, abr = mag * cos(ang), abi = mag * sin(ang), den = lr * lr + li * li;
          const double ur = abr - 1.0, ui = abi, vr = lr / den, vi = -li / den;
          const double zr = ur * vr - ui * vi, zi = ur * vi + ui * vr;
          for (int c = 0; c < 16; ++c) { const double br = (double)a->in[15][idx * 16 + c], bi = (double)a->in[16][idx * 16 + c]; bb[idx * 16 + c] = (f32x2){(float)(zr * br - zi * bi), (float)(zr * bi + zi * br)}; }
      } }
}

__device__ __forceinline__ void phase1_tables(ArgsP a, int gtid, int gthreads) {
    unsigned char* ws = a->ws;
    const f32x2* pw = (const f32x2*)(ws + WS_PW); const f32x2* bb = (const f32x2*)(ws + WS_BBAR);
    float* Kg = (float*)(ws + WS_KG);
    for (int idx = gtid; idx < 32 * 32 * 256; idx += gthreads) {
        const int g = idx >> 13, d = (idx >> 8) & 31, c = (idx >> 4) & 15, cp = idx & 15;
        float s = 0.f;
        for (int p = 0; p < 64; ++p) {
            const float cr = a->in[17][(g * 16 + c) * 64 + p], ci = a->in[18][(g * 16 + c) * 64 + p];
            const f32x2 w = pw[(g * 33 + d) * 64 + p], b = bb[(g * 64 + p) * 16 + cp];
            const float tr = w.x * b.x - w.y * b.y, ti = w.x * b.y + w.y * b.x;
            s += cr * tr - ci * ti;
        }
        Kg[idx] = s;
    }
    bf16* Wst = (bf16*)(ws + WS_WST);
    for (int idx = gtid; idx < 32 * 128 * 64; idx += gthreads) {
        const int g = idx >> 13, n = (idx >> 6) & 127, k0 = (idx & 63) * 8, s = k0 >> 4, c0 = k0 & 15, p = n & 63;
        const f32x2 w = pw[(g * 33 + (31 - s)) * 64 + p];
        float v[8];
#pragma unroll
        for (int i = 0; i < 8; ++i) { const f32x2 b = bb[(g * 64 + p) * 16 + c0 + i]; v[i] = n < 64 ? (w.x * b.x - w.y * b.y) : (w.x * b.y + w.y * b.x); }
        u32x4 o; o.x = pk2(v[0], v[1]); o.y = pk2(v[2], v[3]); o.z = pk2(v[4], v[5]); o.w = pk2(v[6], v[7]);
        *(u32x4*)(Wst + (size_t)idx * 8) = o;
    }
}
__device__ __forceinline__ void phase2_tables(ArgsP a, int gtid, int gthreads) {
    unsigned char* ws = a->ws;
    const f32x2* pw = (const f32x2*)(ws + WS_PW); const float* Kg = (const float*)(ws + WS_KG);
    bf16* W2 = (bf16*)(ws + WS_W2);
    for (int idx = gtid; idx < 32 * 512 * 80; idx += gthreads) {
        const int g = idx / (512 * 80), rem = idx - g * 512 * 80, n = rem / 80, k0 = (rem - n * 80) * 8, t = n >> 4, c = n & 15;
        float v[8];
        if (k0 < 512) {
            const int s = k0 >> 4, c0 = k0 & 15;
#pragma unroll
            for (int i = 0; i < 8; ++i) {
                float x = 0.f;
                if (s <= t) { x = Kg[((g * 32 + (t - s)) * 16 + c) * 16 + c0 + i]; if (s == t && c0 + i == c) x += a->in[19][g * 16 + c]; }
                v[i] = x;
            }
        } else {
            const int part = (k0 - 512) >> 6, p0 = (k0 - 512) & 63;
#pragma unroll
            for (int i = 0; i < 8; ++i) {
                const int p = p0 + i;
                const float cr = a->in[17][(g * 16 + c) * 64 + p], ci = a->in[18][(g * 16 + c) * 64 + p];
                const f32x2 w = pw[(g * 33 + t + 1) * 64 + p];
                v[i] = part == 0 ? (cr * w.x - ci * w.y) : -(cr * w.y + ci * w.x);
            }
        }
        u32x4 o; o.x = pk2(v[0], v[1]); o.y = pk2(v[2], v[3]); o.z = pk2(v[4], v[5]); o.w = pk2(v[6], v[7]);
        *(u32x4*)(W2 + (size_t)idx * 8) = o;
    }
}
__device__ __forceinline__ void phase2_ckv(ArgsP a, int gw, int ngw, int lane) {
    unsigned char* ws = a->ws;
    const bf16* raw = (const bf16*)(ws + WS_CKVRAW); bf16* CK = (bf16*)(ws + WS_CKVALL);
    const f32x4 g4 = *(const f32x4*)(a->in[10] + 4 * lane);
    for (int row = gw; row < MR; row += ngw) {
        const u32x2 r = *(const u32x2*)(raw + (size_t)row * 256 + 4 * lane);
        f32x4 v; v[0] = __uint_as_float(r.x << 16); v[1] = __uint_as_float(r.x & 0xffff0000u); v[2] = __uint_as_float(r.y << 16); v[3] = __uint_as_float(r.y & 0xffff0000u);
        const float s = wave_sum(sumsq4(v));
        const float rs = rsqrtf(s * (1.0f / KVL) + EPS);
        const f32x4 o = v * rs * g4;
        float* dst = row < NP ? a->out + O_PCKV + (size_t)row * 256 : a->out + O_SCKV + (size_t)(row - NP) * 256;
        *(f32x4*)(dst + 4 * lane) = o;
        *(u32x2*)(CK + (size_t)row * 256 + 4 * lane) = pack4(o);
    }
}

constexpr int SG_PITCH = 144, SG_TILE = 128 * SG_PITCH;
template <class Epi>
__device__ __forceinline__ void sgemm_unit(LAS unsigned char* lds, const bf16* A0, int lda0, int nkt0, const bf16* A1, int lda1, int nkt1, int boff1, const bf16* Bt, int ldb, const Epi& E) {
    const int tid = threadIdx.x, lane = tid & 63, wid = tid >> 6, wm = wid >> 2, wn = wid & 3, r32 = lane & 31, hi = lane >> 5;
    const int nkt = nkt0 + nkt1;
    f32x16 acc0 = {}, acc1 = {};
    u32x4 ra[2], rb[2];
    auto gload = [&](int kt) {
#pragma unroll
        for (int i = 0; i < 2; ++i) {
            const int c = tid + 512 * i, row = c >> 3, kc = c & 7;
            const bf16* ap = kt < nkt0 ? A0 + (size_t)row * lda0 + kt * 64 + kc * 8 : A1 + (size_t)row * lda1 + (kt - nkt0) * 64 + kc * 8;
            ra[i] = *(const u32x4*)ap;
            const int bc = kt < nkt0 ? kt * 64 : boff1 + (kt - nkt0) * 64;
            rb[i] = *(const u32x4*)(Bt + (size_t)row * ldb + bc + kc * 8);
        }
    };
    gload(0);
    for (int kt = 0; kt < nkt; ++kt) {
        __syncthreads();
#pragma unroll
        for (int i = 0; i < 2; ++i) { const int c = tid + 512 * i, row = c >> 3, kc = c & 7; *(LAS u32x4*)(lds + row * SG_PITCH + kc * 16) = ra[i]; *(LAS u32x4*)(lds + SG_TILE + row * SG_PITCH + kc * 16) = rb[i]; }
        __syncthreads();
        if (kt + 1 < nkt) gload(kt + 1);
#pragma unroll
        for (int j = 0; j < 4; ++j) {
            const bf16x8 a0 = *(const LAS bf16x8*)(lds + (64 * wm + r32) * SG_PITCH + (16 * j + 8 * hi) * 2);
            const bf16x8 a1 = *(const LAS bf16x8*)(lds + (64 * wm + 32 + r32) * SG_PITCH + (16 * j + 8 * hi) * 2);
            const bf16x8 b = *(const LAS bf16x8*)(lds + SG_TILE + (32 * wn + r32) * SG_PITCH + (16 * j + 8 * hi) * 2);
            acc0 = __builtin_amdgcn_mfma_f32_32x32x16_bf16(a0, b, acc0, 0, 0, 0);
            acc1 = __builtin_amdgcn_mfma_f32_32x32x16_bf16(a1, b, acc1, 0, 0, 0);
        }
    }
#pragma unroll
    for (int r = 0; r < 16; ++r) { const int mm = 64 * wm + (r & 3) + 8 * (r >> 2) + 4 * hi; E(mm, 32 * wn + r32, acc0[r]); E(mm + 32, 32 * wn + r32, acc1[r]); }
}
struct SEpiA { float* S; int m0, g; __device__ __forceinline__ void operator()(int mm, int n, float v) const { const int m = m0 + mm; if (m < NCH) S[((size_t)m * 32 + g) * 128 + n] = v; } };
struct SEpiB { bf16* Z; int m0, n0, g;
    __device__ __forceinline__ void operator()(int mm, int nn, float y) const {
        const int m = m0 + mm, n = n0 + nn; if (m >= NCH) return;
        const float inner = 1.5957691216057308f * (y + 0.044715f * y * y * y);
        const float zv = y * fast_sigmoid(inner);
        Z[((size_t)m * 32 + (n >> 4)) * 512 + g * 16 + (n & 15)] = (bf16)(pk2(zv, 0.f) & 0xffffu);
    } };

__device__ __forceinline__ void s5a_phase(ArgsP a, LAS unsigned char* lds) {
    unsigned char* ws = a->ws;
    for (int unit = blockIdx.x; unit < 32 * 17; unit += gridDim.x) {
        const int g = unit / 17, mt = unit % 17;
        SEpiA E{(float*)(ws + WS_S), mt * 128, g};
        const bf16* A0 = (const bf16*)(ws + WS_U2) + (size_t)g * MR * 16 + (size_t)mt * 128 * 512;
        sgemm_unit(lds, A0, 512, 8, A0, 512, 0, 0, (const bf16*)(ws + WS_WST) + (size_t)g * 128 * 512, 512, E);
    }
    __syncthreads();
}
__device__ __forceinline__ void s5b_phase(ArgsP a, LAS unsigned char* lds) {
    unsigned char* ws = a->ws;
    for (int unit = blockIdx.x; unit < 32 * 17 * 4; unit += gridDim.x) {
        const int g = unit / 68, mt = (unit % 68) >> 2, nt = unit & 3;
        SEpiB E{(bf16*)(ws + WS_Z), mt * 128, nt * 128, g};
        const bf16* A0 = (const bf16*)(ws + WS_U2) + (size_t)g * MR * 16 + (size_t)mt * 128 * 512;
        const bf16* A1 = (const bf16*)(ws + WS_XPREV) + ((size_t)mt * 128 * 32 + g) * 128;
        sgemm_unit(lds, A0, 512, 2 * nt + 2, A1, 32 * 128, 2, 512, (const bf16*)(ws + WS_W2) + ((size_t)g * 512 + nt * 128) * 640, 640, E);
    }
    __syncthreads();
}
__device__ __forceinline__ void s5_carry(ArgsP a, int gtid, int gthreads) {
    unsigned char* ws = a->ws;
    const f32x2* pw = (const f32x2*)(ws + WS_PW); const float* S = (const float*)(ws + WS_S); bf16* XP = (bf16*)(ws + WS_XPREV);
    for (int idx = gtid; idx < 2 * 65536; idx += gthreads) {
        const int j = idx & 65535, b = j >> 11, g = (j >> 6) & 31, p = j & 63;
        const f32x2 w = pw[(g * 33 + 32) * 64 + p];
        if (idx < 65536) {
            float xr = 0.f, xi = 0.f;
#pragma unroll 8
            for (int c = 0; c < 64; ++c) {
                const size_t o = ((size_t)(b * 64 + c) * 32 + g) * 128 + p;
                XP[o] = (bf16)(pk2(xr, 0.f) & 0xffffu); XP[o + 64] = (bf16)(pk2(xi, 0.f) & 0xffffu);
                const float sr = S[o], si = S[o + 64];
                const float nr = w.x * xr - w.y * xi + sr, ni = w.x * xi + w.y * xr + si;
                xr = nr; xi = ni;
            }
            a->out[O_PRE + j] = xr; a->out[O_PIM + j] = xi;
        } else {
            const float x0r = a->in[4][j], x0i = a->in[5][j];
            const size_t o = ((size_t)(2048 + b) * 32 + g) * 128 + p;
            XP[o] = (bf16)(pk2(x0r, 0.f) & 0xffffu); XP[o + 64] = (bf16)(pk2(x0i, 0.f) & 0xffffu);
            a->out[O_SRE + j] = w.x * x0r - w.y * x0i + S[o]; a->out[O_SIM + j] = w.x * x0i + w.y * x0r + S[o + 64];
        }
    }
}

constexpr int AT_KP = 208, AT_VP = 144, AT_VOFF = 64 * AT_KP  , AT_TB = AT_VOFF + 64 * AT_VP  ;
__device__ __forceinline__ void attn_unit(LAS unsigned char* lds, const bf16* Q, const bf16* KN, const bf16* KR, const bf16* Vt, bf16* MIX, int h,
                                          size_t qrow0, bool active, int nt_w, int NT, size_t krow0, size_t krow_last, int nvalid_last) {
    const int tid = threadIdx.x, lane = tid & 63, r32 = lane & 31, hi = lane >> 5;
    bf16x8 qf[6];
    if (active) {
        const bf16* qp = Q + (qrow0 + r32) * 768;
#pragma unroll
        for (int j = 0; j < 4; ++j) qf[j] = *(const bf16x8*)(qp + h * 64 + 16 * j + 8 * hi);
#pragma unroll
        for (int j = 0; j < 2; ++j) qf[4 + j] = *(const bf16x8*)(qp + 512 + h * 32 + 16 * j + 8 * hi);
    } else {
#pragma unroll
        for (int j = 0; j < 6; ++j) qf[j] = (bf16x8){0, 0, 0, 0, 0, 0, 0, 0};
    }
    f32x16 ot0 = {}, ot1 = {};
    float m_run = -1e30f, lsum = 0.f;
    u32x4 rkn, rkr = {0, 0, 0, 0}, rvt;
    auto gload = [&](int t) {
        const size_t kb = (nvalid_last < 64 && t == NT - 1) ? krow_last : krow0 + (size_t)64 * t;
        rkn = *(const u32x4*)(KN + (kb + (tid >> 3)) * 512 + h * 64 + (tid & 7) * 8);
        if (tid < 256) rkr = *(const u32x4*)(KR + (kb + (tid >> 2)) * 32 + (tid & 3) * 8);
        rvt = *(const u32x4*)(Vt + (size_t)(h * 64 + (tid >> 3)) * MKV + kb + (tid & 7) * 8);
    };
    const int pi_r = (r32 & 0x13) | ((r32 & 4) << 1) | ((r32 & 8) >> 1);
    gload(0);
    for (int t = 0; t < NT; ++t) {
        LAS unsigned char* tb = lds + (t & 1) * AT_TB;
        *(LAS u32x4*)(tb + (tid >> 3) * AT_KP + (tid & 7) * 16) = rkn;
        if (tid < 256) *(LAS u32x4*)(tb + (tid >> 2) * AT_KP + 128 + (tid & 3) * 16) = rkr;
        *(LAS u32x4*)(tb + AT_VOFF + (tid >> 3) * AT_VP + (tid & 7) * 16) = rvt;
        __syncthreads();
        if (t + 1 < NT) gload(t + 1);
        if (active && t < nt_w) {
            f32x16 p0 = {}, p1 = {};
            const LAS unsigned char* kp = tb + pi_r * AT_KP + hi * 16;
#pragma unroll
            for (int j = 0; j < 6; ++j) {
                const bf16x8 a0 = *(const LAS bf16x8*)(kp + j * 32), a1 = *(const LAS bf16x8*)(kp + 32 * AT_KP + j * 32);
                p0 = __builtin_amdgcn_mfma_f32_32x32x16_bf16(a0, qf[j], p0, 0, 0, 0);
                p1 = __builtin_amdgcn_mfma_f32_32x32x16_bf16(a1, qf[j], p1, 0, 0, 0);
            }
            if (nvalid_last < 64 && t == NT - 1) {
#pragma unroll
                for (int r = 0; r < 16; ++r) { const int key = (r & 7) + 8 * hi + 16 * (r >> 3); if (key >= nvalid_last) p0[r] = -1e30f; if (key + 32 >= nvalid_last) p1[r] = -1e30f; }
            }
            float mx = fmaxf(p0[0], p1[0]);
#pragma unroll
            for (int r = 1; r < 16; ++r) mx = fmaxf(mx, fmaxf(p0[r], p1[r]));
            mx = fmaxf(mx, __shfl_xor(mx, 32));
            const float mnew = fmaxf(m_run, mx), alpha = __builtin_amdgcn_exp2f(m_run - mnew);
            m_run = mnew;
            float ps = 0.f;
#pragma unroll
            for (int r = 0; r < 16; ++r) { p0[r] = __builtin_amdgcn_exp2f(p0[r] - mnew); p1[r] = __builtin_amdgcn_exp2f(p1[r] - mnew); ps += p0[r] + p1[r]; }
            lsum = lsum * alpha + ps;
            ot0 = ot0 * alpha; ot1 = ot1 * alpha;
            bf16x8 pf[4];
            { u32x4 w;
              w.x = pk2(p0[0], p0[1]); w.y = pk2(p0[2], p0[3]); w.z = pk2(p0[4], p0[5]); w.w = pk2(p0[6], p0[7]); pf[0] = __builtin_bit_cast(bf16x8, w);
              w.x = pk2(p0[8], p0[9]); w.y = pk2(p0[10], p0[11]); w.z = pk2(p0[12], p0[13]); w.w = pk2(p0[14], p0[15]); pf[1] = __builtin_bit_cast(bf16x8, w);
              w.x = pk2(p1[0], p1[1]); w.y = pk2(p1[2], p1[3]); w.z = pk2(p1[4], p1[5]); w.w = pk2(p1[6], p1[7]); pf[2] = __builtin_bit_cast(bf16x8, w);
              w.x = pk2(p1[8], p1[9]); w.y = pk2(p1[10], p1[11]); w.z = pk2(p1[12], p1[13]); w.w = pk2(p1[14], p1[15]); pf[3] = __builtin_bit_cast(bf16x8, w); }
            const LAS unsigned char* vp = tb + AT_VOFF + r32 * AT_VP + hi * 16;
#pragma unroll
            for (int jj = 0; jj < 4; ++jj) {
                const bf16x8 v0 = *(const LAS bf16x8*)(vp + jj * 32), v1 = *(const LAS bf16x8*)(vp + 32 * AT_VP + jj * 32);
                ot0 = __builtin_amdgcn_mfma_f32_32x32x16_bf16(v0, pf[jj], ot0, 0, 0, 0);
                ot1 = __builtin_amdgcn_mfma_f32_32x32x16_bf16(v1, pf[jj], ot1, 0, 0, 0);
            }
        }
    }
    if (active) {
        const float l = lsum + __shfl_xor(lsum, 32), inv = 1.0f / l;
        bf16* op = MIX + (qrow0 + r32) * 1024 + h * 64 + 4 * hi;
#pragma unroll
        for (int c = 0; c < 4; ++c) {
            u32x2 w; w.x = pk2(ot0[4 * c] * inv, ot0[4 * c + 1] * inv); w.y = pk2(ot0[4 * c + 2] * inv, ot0[4 * c + 3] * inv); *(u32x2*)(op + 8 * c) = w;
            w.x = pk2(ot1[4 * c] * inv, ot1[4 * c + 1] * inv); w.y = pk2(ot1[4 * c + 2] * inv, ot1[4 * c + 3] * inv); *(u32x2*)(op + 32 + 8 * c) = w;
        }
    }
    __syncthreads();
}
__device__ __forceinline__ void attn_phase(ArgsP a, LAS unsigned char* lds) {
    unsigned char* ws = a->ws;
    const bf16* Q = (const bf16*)(ws + WS_Q); const bf16* KN = (const bf16*)(ws + WS_KN); const bf16* KR = (const bf16*)(ws + WS_KR); const bf16* Vt = (const bf16*)(ws + WS_VT); bf16* MIX = (bf16*)(ws + WS_MIX);
    const int wid = threadIdx.x >> 6;
    for (int v = blockIdx.x; v < 256; v += gridDim.x) {
        const int b = v >> 3, h = v & 7;
        for (int qb = 7; qb >= 0; --qb)
            attn_unit(lds, Q, KN, KR, Vt, MIX, h, (size_t)b * SEQ + 256 * qb + 32 * wid, true, 4 * qb + (wid >> 1) + 1, 4 * qb + 4, (size_t)b * SEQ, 0, 64);
        attn_unit(lds, Q, KN, KR, Vt, MIX, h, (size_t)NP + b * DECS, wid == 0, 33, 33, (size_t)MR + (size_t)b * PAST, (size_t)NP + b * DECS, 32);
    }
}

__device__ __forceinline__ void mixnorm_phase(ArgsP a, int gw, int ngw, int lane) {
    bf16* MIX = (bf16*)(a->ws + WS_MIX);
    for (int row = gw; row < MR; row += ngw) {
        bf16* p = MIX + (size_t)row * 1024 + 16 * lane;
        const u32x4 r0 = *(const u32x4*)p, r1 = *(const u32x4*)(p + 8);
        float v[16];
        const unsigned w[8] = {r0.x, r0.y, r0.z, r0.w, r1.x, r1.y, r1.z, r1.w};
        float s = 0.f;
#pragma unroll
        for (int i = 0; i < 8; ++i) { v[2 * i] = __uint_as_float(w[i] << 16); v[2 * i + 1] = __uint_as_float(w[i] & 0xffff0000u); s += v[2 * i] * v[2 * i] + v[2 * i + 1] * v[2 * i + 1]; }
#pragma unroll
        for (int o = 1; o < 32; o <<= 1) s += __shfl_xor(s, o);
        const float rs = rsqrtf(s * (1.0f / 512) + EPS);
        u32x4 o0, o1;
        o0.x = pk2(v[0] * rs, v[1] * rs); o0.y = pk2(v[2] * rs, v[3] * rs); o0.z = pk2(v[4] * rs, v[5] * rs); o0.w = pk2(v[6] * rs, v[7] * rs);
        o1.x = pk2(v[8] * rs, v[9] * rs); o1.y = pk2(v[10] * rs, v[11] * rs); o1.z = pk2(v[12] * rs, v[13] * rs); o1.w = pk2(v[14] * rs, v[15] * rs);
        *(u32x4*)p = o0; *(u32x4*)(p + 8) = o1;
    }
}
__device__ __forceinline__ void final_phase(ArgsP a, int gw, int ngw, int lane) {
    float* Y = a->out + O_Y; const float* gf = a->in[29];
    f32x4 g4[4];
#pragma unroll
    for (int j = 0; j < 4; ++j) g4[j] = *(const f32x4*)(gf + 4 * lane + 256 * j);
    for (int row = gw; row < MR; row += ngw) {
        float* p = Y + (size_t)row * DM + 4 * lane;
        f32x4 v[4]; float s = 0.f;
#pragma unroll
        for (int j = 0; j < 4; ++j) { v[j] = *(const f32x4*)(p + 256 * j); s += sumsq4(v[j]); }
        s = wave_sum(s);
        const float rs = rsqrtf(s * (1.0f / DM) + EPS);
#pragma unroll
        for (int j = 0; j < 4; ++j) *(f32x4*)(p + 256 * j) = v[j] * rs * g4[j];
    }
}

constexpr int LDS_BYTES = 131072 + 1024;
constexpr int NPHASE = 11;
template <class Epi>
__device__ __forceinline__ void run_gemm(LAS unsigned char* lds, const bf16* A, const bf16* Bt, int M, int N, int K, const Epi& E) {
    asm volatile("" : "+s"(K));
    pg8::Gemm g{A, Bt, M, N, K}; pg8::StaticOrder S; S.init(M, N, (int)gridDim.x, (int)blockIdx.x);
    pg8::gemm_phase<Epi, pg8::StaticOrder, true, true>(lds, g, S, E);
    __syncthreads();
}

__global__ void __launch_bounds__(NTHR, 2) mega_fwd(Args a_unused) {
    extern __shared__ __attribute__((aligned(16))) unsigned char lds_raw[];
    LAS unsigned char* lds = (LAS unsigned char*)lds_raw;
    ArgsP a = (ArgsP)__builtin_amdgcn_kernarg_segment_ptr();
#define TID_VARS const int tid = threadIdx.x, lane = tid & 63, wave = tid >> 6; const int gtid = blockIdx.x * NTHR + tid, gthreads = gridDim.x * NTHR, gw = blockIdx.x * 8 + wave, ngw = gridDim.x * 8; (void)lane; (void)gtid; (void)gthreads; (void)gw; (void)ngw;
#define ws (a->ws)
    const int lo = a->ph_lo, hi = a->ph_hi;
    volatile LAS unsigned* bst = (volatile LAS unsigned*)(lds + 131072);
    if (threadIdx.x < 4) bst[threadIdx.x] = 0u;
    __syncthreads();
    XcdBarrier bar = xcd_barrier_post((unsigned*)(ws + WS_CTL), bst);
    if (lo < 0) cg::this_grid().sync();
#ifndef PHASE_MASK
#define PHASE_MASK 0xfffff
#endif
#define IN(k) (((PHASE_MASK >> (k)) & 1) && lo <= (k) && (k) < hi)
#define SEAM(k) do { if (IN(k) && IN((k) + 1)) { xcd_barrier(bar); } } while (0)

    if (IN(0)) { TID_VARS phase0(a, gtid, gthreads, gw, ngw, lane); }
    SEAM(0);
    if (IN(1)) {
        { TID_VARS phase1_tables(a, gtid, gthreads); }
        EpiG1 E{(bf16*)(ws + WS_CKVRAW), (bf16*)(ws + WS_CQ), (bf16*)(ws + WS_U2), (float*)(ws + WS_SSQQ), (const float*)(ws + WS_RSX), (const float*)(ws + WS_ROPE), a->out, (bf16*)(ws + WS_KR)};
        run_gemm(lds, (const bf16*)(ws + WS_XB), (const bf16*)(ws + WS_WIN), MR, 1280, 1024, E);
    }
    SEAM(1);
    if (IN(2)) {
#ifndef SKIP_2A
        { TID_VARS phase2_tables(a, gtid, gthreads); phase2_ckv(a, gw, ngw, lane); }
#endif
#ifndef SKIP_2B
        EpiG2 E{(bf16*)(ws + WS_Q), (const float*)(ws + WS_SSQQ), (const float*)(ws + WS_ROPE)};
        run_gemm(lds, (const bf16*)(ws + WS_CQ), (const bf16*)(ws + WS_WUQ), MR, 768, 384, E);
#endif
#ifndef SKIP_2C
        s5a_phase(a, lds);
#endif
    }
    SEAM(2);
    if (IN(3)) {
#ifndef SKIP_3A
        { TID_VARS s5_carry(a, gtid, gthreads); }
#endif
#ifndef SKIP_3B
        { pg8::EpiBf16<0> E{(bf16*)(ws + WS_KN), 512, nullptr, 0, 0, 1.f};
          run_gemm(lds, (const bf16*)(ws + WS_CKVALL), (const bf16*)(ws + WS_WUK), MKV, 512, 256, E); }
#endif
#ifndef SKIP_3C
        { pg8::EpiBf16<0> E{(bf16*)(ws + WS_VT), MKV, nullptr, 0, 0, 1.f};
          run_gemm(lds, (const bf16*)(ws + WS_WUV), (const bf16*)(ws + WS_CKVALL), 512, MKV, 256, E); }
#endif
    }
    SEAM(3);
    if (IN(4)) { attn_phase(a, lds); s5b_phase(a, lds); }
    SEAM(4);
    if (IN(5)) {
        EpiGLU E{(const bf16*)(ws + WS_Z), a->in[21], (bf16*)(ws + WS_MIX)};
        run_gemm(lds, (const bf16*)(ws + WS_Z), (const bf16*)(ws + WS_WGLU), MR, 512, 512, E);
    }
    SEAM(5);
    if (IN(6)) { TID_VARS mixnorm_phase(a, gw, ngw, lane); }
    SEAM(6);
    if (IN(7)) {
        EpiOut E{a->in[0], a->in[1], a->out + O_Y, (bf16*)(ws + WS_X1B), (float*)(ws + WS_SSQF)};
        run_gemm(lds, (const bf16*)(ws + WS_MIX), (const bf16*)(ws + WS_WOUT), MR, 1024, 1024, E);
    }
    SEAM(7);
    if (IN(8)) {
        EpiGU E{(bf16*)(ws + WS_HID), (const float*)(ws + WS_SSQF)};
        run_gemm(lds, (const bf16*)(ws + WS_X1B), (const bf16*)(ws + WS_WGU), MR, 5632, 1024, E);
    }
    SEAM(8);
    if (IN(9)) {
        EpiDown E{a->out + O_Y};
        run_gemm(lds, (const bf16*)(ws + WS_HID), (const bf16*)(ws + WS_WDN), MR, 1024, DFF, E);
    }
    SEAM(9);
    if (IN(10)) { TID_VARS final_phase(a, gw, ngw, lane); }
#undef IN
#undef SEAM
#undef ws
}

extern "C" void kernel_launch(void* const* d_in, const int* in_sizes, int n_in, void* d_out, int out_size, void* d_ws, size_t ws_size, hipStream_t stream) {
    static int grid = 0;
    if (grid == 0) {
        if (n_in != 30 || ws_size < WS_END) { fprintf(stderr, "kernel_launch: unexpected n_in %d / ws_size %zu\n", n_in, ws_size); grid = -1; return; }
        int dev = 0, cus = 0, per_cu = 0;
        hipGetDevice(&dev); hipDeviceGetAttribute(&cus, hipDeviceAttributeMultiprocessorCount, dev);
        if (hipFuncSetAttribute((const void*)mega_fwd, hipFuncAttributeMaxDynamicSharedMemorySize, LDS_BYTES) != hipSuccess) { fprintf(stderr, "kernel_launch: hipFuncSetAttribute failed\n"); grid = -1; return; }
        if (hipOccupancyMaxActiveBlocksPerMultiprocessor(&per_cu, (const void*)mega_fwd, NTHR, LDS_BYTES) != hipSuccess || per_cu < 1) { fprintf(stderr, "kernel_launch: occupancy query says %d\n", per_cu); per_cu = 1; }
        (void)hipGetLastError();
        grid = cus * 1;
        if (grid <= 0) grid = 256;
    }
    if (grid < 0) return;
    Args a{};
    for (int i = 0; i < 30; ++i) a.in[i] = (const float*)d_in[i];
    a.out = (float*)d_out; a.ws = (unsigned char*)d_ws;
    (void)hipMemsetAsync((unsigned char*)d_ws + WS_CTL, 0, CTL_BYTES, stream);
#if ONE_LAUNCH
    a.ph_lo = 0; a.ph_hi = NPHASE;
    void* args[] = {&a};
    hipError_t e = hipLaunchCooperativeKernel((const void*)mega_fwd, dim3(grid), dim3(NTHR), args, LDS_BYTES, stream);
    if (e != hipSuccess) fprintf(stderr, "cooperative launch failed: %s (grid %d)\n", hipGetErrorString(e), grid);
#else
    for (int ph = 0; ph < NPHASE; ++ph) {
        a.ph_lo = ph; a.ph_hi = ph + 1;
        hipLaunchKernelGGL(mega_fwd, dim3(grid), dim3(NTHR), LDS_BYTES, stream, a);
    }
#endif
}
```
